# Optimizing an MI355X kernel written in HIP

```python
import jax
import jax.numpy as jnp
from jax import lax
import numpy as np

D_MODEL = 1024
BATCH = 16
SEQ = 4096
DEPTH = 1

GRID_W = 64
CTX_LEN = 256
MIX_WIDTH = D_MODEL
HG_WIDTH = MIX_WIDTH // 2
HG_HEADS = 4
HG_KEY = HG_WIDTH // HG_HEADS
HG_VAL = HG_WIDTH // HG_HEADS
HG_CHUNK = 64
HG_SUB = 16
LOG_F_MIN = -4.0
ATT_WIDTH = MIX_WIDTH - HG_WIDTH
HEAD_DIM = 64
ATT_Q_HEADS = ATT_WIDTH // HEAD_DIM
ATT_KV_HEADS = 2
ATT_GROUP = ATT_Q_HEADS // ATT_KV_HEADS
WINDOW = 128
ATT_BLOCK = 128
ROPE_BASE = 10000.0
ROT_PAIRS = HEAD_DIM // 4
IN_COLS = 5 * HG_WIDTH + (ATT_Q_HEADS + 2 * ATT_KV_HEADS) * HEAD_DIM
N_EXPERTS = 64
TOP_K = 8
N_GROUPS = 8
TOPK_GROUPS = 4
EXPERT_FF = D_MODEL // 4
ROUTED_SCALE = 2.5
LN_EPS = 1e-5
NORM_EPS = 1e-6

kernel_name = 'hymba_hgrn2_swa_moe_dit_layer'


def layer_norm(x, w=None, b=None, eps=LN_EPS):
    x32 = x.astype(jnp.float32)
    mu = jnp.mean(x32, axis=-1, keepdims=True)
    xc = x32 - mu
    y = xc * lax.rsqrt(jnp.mean(xc * xc, axis=-1, keepdims=True) + eps)
    if w is not None:
        y = y * w.astype(jnp.float32) + b.astype(jnp.float32)
    return y.astype(x.dtype)


def modulate(x, shift, scale):
    return layer_norm(x, eps=NORM_EPS) * (1.0 + scale) + shift


def split_columns(z):
    sizes = [HG_WIDTH] * 5 + [ATT_Q_HEADS * HEAD_DIM, ATT_KV_HEADS * HEAD_DIM, ATT_KV_HEADS * HEAD_DIM]
    bounds = [int(v) for v in np.cumsum(sizes)[:-1]]
    return jnp.split(z, bounds, axis=-1)


def rope_2d_angles(n):
    rows = n // GRID_W
    row = jnp.repeat(jnp.arange(rows), GRID_W).astype(jnp.float32)
    col = jnp.tile(jnp.arange(GRID_W), rows).astype(jnp.float32)
    freqs = ROPE_BASE ** (-jnp.arange(ROT_PAIRS, dtype=jnp.float32) / ROT_PAIRS)
    return row[:, None] * freqs, col[:, None] * freqs


def rotate(x, ang):
    x1, x2 = jnp.split(x.astype(jnp.float32), 2, axis=-1)
    cos = jnp.cos(ang)[:, None, :]
    sin = jnp.sin(ang)[:, None, :]
    return jnp.concatenate([x1 * cos - x2 * sin, x1 * sin + x2 * cos], axis=-1)


def apply_rope_2d(x, ang_row, ang_col):
    half = HEAD_DIM // 2
    y = jnp.concatenate([rotate(x[..., :half], ang_row), rotate(x[..., half:], ang_col)], axis=-1)
    return y.astype(x.dtype)


def hgrn2_scan(q, k, v, logf, s0, with_output):
    bsz, nh, n, dk = q.shape
    dv = v.shape[-1]
    nc = n // HG_CHUNK
    ns = HG_CHUNK // HG_SUB

    def chunked(t):
        return jnp.moveaxis(t.reshape(bsz, nh, nc, HG_CHUNK, t.shape[-1]), 2, 0)

    pos = jnp.arange(HG_CHUNK)
    causal = pos[:, None] >= pos[None, :]
    key_ok = pos[None, :] < (jnp.arange(ns)[:, None] + 1) * HG_SUB

    def step(s, inp):
        qc, kc, vc, gc = inp
        bcum = jnp.cumsum(gc, axis=-2)
        b_last = bcum[:, :, -1:, :]
        s_new = jnp.exp(b_last[:, :, 0, :])[..., None] * s + jnp.einsum(
            'bhcd,bhce->bhde', kc * jnp.exp(b_last - bcum), vc)
        if not with_output:
            return s_new, None
        bsub = bcum.reshape(bsz, nh, ns, HG_SUB, dk)
        ref = jnp.concatenate([jnp.zeros_like(bsub[:, :, :1, 0]), bsub[:, :, :-1, -1]], axis=2)
        q_hat = qc.reshape(bsz, nh, ns, HG_SUB, dk) * jnp.exp(bsub - ref[:, :, :, None])
        e = ref[:, :, :, None, :] - bcum[:, :, None, :, :]
        e = jnp.where(key_ok[None, None, :, :, None], e, -jnp.inf)
        k_hat = kc[:, :, None] * jnp.exp(e)
        att = jnp.einsum('bhnid,bhnjd->bhnij', q_hat, k_hat).reshape(bsz, nh, HG_CHUNK, HG_CHUNK)
        att = jnp.where(causal, att, 0.0)
        o = jnp.einsum('bhij,bhje->bhie', att, vc) + jnp.einsum(
            'bhid,bhde->bhie', qc * jnp.exp(bcum), s)
        return s_new, o

    s_fin, o = lax.scan(step, s0, (chunked(q), chunked(k), chunked(v), chunked(logf)))
    if with_output:
        o = jnp.moveaxis(o, 0, 2).reshape(bsz, nh, n, dv)
    return o, s_fin


def hgrn2_group(z_q, z_ff, z_fb, z_i, lb_f, lb_b, s0_f, s0_b, with_output):
    bsz, n, _ = z_q.shape

    def heads(t):
        return t.astype(jnp.float32).reshape(bsz, n, HG_HEADS, -1).transpose(0, 2, 1, 3)

    def gates(zf, lb):
        lb32 = lb.astype(jnp.float32)
        f = lb32 + (1.0 - lb32) * jax.nn.sigmoid(zf.astype(jnp.float32))
        return heads(1.0 - f), heads(jnp.maximum(jnp.log(f), LOG_F_MIN))

    q = heads(z_q)
    v = heads(z_i)
    k_f, g_f = gates(z_ff, lb_f)
    k_b, g_b = gates(z_fb, lb_b)
    rev = lambda t: jnp.flip(t, axis=2)
    o_f, s_f = hgrn2_scan(q, k_f, v, g_f, s0_f, with_output)
    o_b, s_b = hgrn2_scan(rev(q), rev(k_b), rev(v), rev(g_b), s0_b, with_output)
    o = o_f + rev(o_b) if with_output else None
    return o, s_f, s_b


def hgrn2_readout(o, z_g, norm_w):
    bsz, nh, n, dv = o.shape
    o = o.transpose(0, 2, 1, 3)
    o = o * lax.rsqrt(jnp.mean(o * o, axis=-1, keepdims=True) + NORM_EPS)
    o = o.reshape(bsz, n, nh * dv) * norm_w.astype(jnp.float32)
    return (o * jax.nn.silu(z_g.astype(jnp.float32))).astype(z_g.dtype)


def attn_context(q, k_ctx, v_ctx, sink):
    bsz, l, _, _ = q.shape
    qg = q.reshape(bsz, l, ATT_KV_HEADS, ATT_GROUP, HEAD_DIM)
    s = jnp.einsum('blhgd,bmhd->bhglm', qg, k_ctx).astype(jnp.float32) * HEAD_DIM ** -0.5
    sink_col = jnp.broadcast_to(sink.astype(jnp.float32).reshape(ATT_KV_HEADS, ATT_GROUP)[None, :, :, None, None],
                                (bsz, ATT_KV_HEADS, ATT_GROUP, l, 1))
    p = jax.nn.softmax(jnp.concatenate([sink_col, s], axis=-1), axis=-1)[..., 1:].astype(v_ctx.dtype)
    o = jnp.einsum('bhglm,bmhd->blhgd', p, v_ctx)
    return o.reshape(bsz, l, ATT_Q_HEADS * HEAD_DIM)


def attn_latent_window(q, k, v, k_ctx, v_ctx, sink):
    bsz, n, _, _ = q.shape
    l = k_ctx.shape[1]
    nb = n // ATT_BLOCK
    pad = ((0, 0), (ATT_BLOCK, ATT_BLOCK), (0, 0), (0, 0))
    kp = jnp.pad(k, pad)
    vp = jnp.pad(v, pad)
    qi = jnp.arange(ATT_BLOCK)
    kj = jnp.arange(3 * ATT_BLOCK)
    scale = HEAD_DIM ** -0.5
    sink_col = jnp.broadcast_to(sink.astype(jnp.float32).reshape(ATT_KV_HEADS, ATT_GROUP)[None, :, :, None, None],
                                (bsz, ATT_KV_HEADS, ATT_GROUP, ATT_BLOCK, 1))

    def band(bidx):
        start = bidx * ATT_BLOCK
        qb = lax.dynamic_slice_in_dim(q, start, ATT_BLOCK, axis=1).reshape(
            bsz, ATT_BLOCK, ATT_KV_HEADS, ATT_GROUP, HEAD_DIM)
        kb = lax.dynamic_slice_in_dim(kp, start, 3 * ATT_BLOCK, axis=1)
        vb = lax.dynamic_slice_in_dim(vp, start, 3 * ATT_BLOCK, axis=1)
        qpos = start + qi
        kpos = start - ATT_BLOCK + kj
        ok = (jnp.abs(kpos[None, :] - qpos[:, None]) <= WINDOW) & (kpos >= 0)[None, :] & (kpos < n)[None, :]
        s_w = jnp.einsum('bqhgd,bkhd->bhgqk', qb, kb).astype(jnp.float32) * scale
        s_w = jnp.where(ok, s_w, -jnp.inf)
        s_c = jnp.einsum('bqhgd,bmhd->bhgqm', qb, k_ctx).astype(jnp.float32) * scale
        p = jax.nn.softmax(jnp.concatenate([sink_col, s_c, s_w], axis=-1), axis=-1).astype(v.dtype)
        o = jnp.einsum('bhgqm,bmhd->bqhgd', p[..., 1:1 + l], v_ctx) + jnp.einsum(
            'bhgqk,bkhd->bqhgd', p[..., 1 + l:], vb)
        return o.reshape(bsz, ATT_BLOCK, ATT_Q_HEADS * HEAD_DIM)

    out = lax.map(band, jnp.arange(nb))
    return jnp.moveaxis(out, 0, 1).reshape(bsz, n, ATT_Q_HEADS * HEAD_DIM)


def mixer_context(h, w_in, lb_f, lb_b, norm_w, sink, with_output):
    bsz, l, _ = h.shape
    zq, zff, zfb, zi, zg, aq, ak, av = split_columns(h @ w_in)
    k_ctx = ak.reshape(bsz, l, ATT_KV_HEADS, HEAD_DIM)
    v_ctx = av.reshape(bsz, l, ATT_KV_HEADS, HEAD_DIM)
    s0 = jnp.zeros((bsz, HG_HEADS, HG_KEY, HG_VAL), jnp.float32)
    o_h, s_f, s_b = hgrn2_group(zq, zff, zfb, zi, lb_f, lb_b, s0, s0, with_output)
    if not with_output:
        return None, k_ctx, v_ctx, s_f, s_b
    y_h = hgrn2_readout(o_h, zg, norm_w)
    y_a = attn_context(aq.reshape(bsz, l, ATT_Q_HEADS, HEAD_DIM), k_ctx, v_ctx, sink)
    return jnp.concatenate([y_h, y_a.astype(y_h.dtype)], axis=-1), k_ctx, v_ctx, s_f, s_b


def mixer_latent(h, w_in, lb_f, lb_b, norm_w, sink, k_ctx, v_ctx, s_f, s_b, ang_row, ang_col):
    bsz, n, _ = h.shape
    zq, zff, zfb, zi, zg, aq, ak, av = split_columns(h @ w_in)
    o_h, _, _ = hgrn2_group(zq, zff, zfb, zi, lb_f, lb_b, s_f, s_b, True)
    y_h = hgrn2_readout(o_h, zg, norm_w)
    q = apply_rope_2d(aq.reshape(bsz, n, ATT_Q_HEADS, HEAD_DIM), ang_row, ang_col)
    k = apply_rope_2d(ak.reshape(bsz, n, ATT_KV_HEADS, HEAD_DIM), ang_row, ang_col)
    v = av.reshape(bsz, n, ATT_KV_HEADS, HEAD_DIM)
    y_a = attn_latent_window(q, k, v, k_ctx, v_ctx, sink)
    return jnp.concatenate([y_h, y_a.astype(y_h.dtype)], axis=-1)


def swiglu(h, wg, wu, wd):
    return (jax.nn.silu(h @ wg) * (h @ wu)) @ wd


def moe(h, router_w, router_bias, w_gate, w_up, w_down, sw_gate, sw_up, sw_down):
    shape = h.shape
    ht = h.reshape(-1, shape[-1])
    t = ht.shape[0]
    scores = jax.nn.sigmoid(ht.astype(jnp.float32) @ router_w.astype(jnp.float32))
    sel = scores + router_bias.astype(jnp.float32)
    grp = sel.reshape(t, N_GROUPS, N_EXPERTS // N_GROUPS)
    grp_score = jnp.sum(lax.top_k(grp, 2)[0], axis=-1)
    _, gidx = lax.top_k(grp_score, TOPK_GROUPS)
    rows = jnp.arange(t)[:, None]
    gmask = jnp.zeros((t, N_GROUPS), bool).at[rows, gidx].set(True)
    emask = jnp.repeat(gmask, N_EXPERTS // N_GROUPS, axis=1)
    _, eidx = lax.top_k(jnp.where(emask, sel, -jnp.inf), TOP_K)
    w = jnp.take_along_axis(scores, eidx, axis=-1)
    w = w / jnp.sum(w, axis=-1, keepdims=True) * ROUTED_SCALE
    gates = jnp.zeros((t, N_EXPERTS), jnp.float32).at[rows, eidx].set(w).astype(h.dtype)
    y = swiglu(ht, sw_gate, sw_up, sw_down)
    for e in range(N_EXPERTS):
        y = y + gates[:, e:e + 1] * swiglu(ht, w_gate[e], w_up[e], w_down[e])
    return y.reshape(shape)


def setup_inputs(seed: int = 0) -> dict:
    key = jax.random.key(seed)
    ks = jax.random.split(key, 32)
    beta = (8.0 * DEPTH) ** -0.25

    def nrm(k, shape, s):
        return jax.random.normal(k, shape, jnp.float32) * s

    return {
        'x': nrm(ks[0], (BATCH, SEQ, D_MODEL), 1.0),
        'c': nrm(ks[1], (BATCH, D_MODEL), 1.0),
        'ctx': nrm(ks[2], (BATCH, CTX_LEN, D_MODEL), 1.0),
        'c_ctx': nrm(ks[3], (D_MODEL,), 1.0),
        'w_ada': nrm(ks[4], (DEPTH, D_MODEL, 6 * D_MODEL), 0.5 * D_MODEL ** -0.5),
        'b_ada': nrm(ks[5], (DEPTH, 6 * D_MODEL), 0.02),
        'w_in': nrm(ks[6], (DEPTH, D_MODEL, IN_COLS), D_MODEL ** -0.5),
        'hg_lb_fwd': nrm(ks[7], (DEPTH + 1, HG_WIDTH), 0.1),
        'hg_lb_bwd': nrm(ks[8], (DEPTH + 1, HG_WIDTH), 0.1),
        'hg_norm_w': 1.0 + nrm(ks[9], (DEPTH, HG_WIDTH), 0.02),
        'attn_sink': nrm(ks[10], (DEPTH, ATT_Q_HEADS), 0.5),
        'w_out': nrm(ks[11], (DEPTH, MIX_WIDTH, D_MODEL), beta * MIX_WIDTH ** -0.5),
        'ln1_w': 1.0 + nrm(ks[12], (DEPTH, D_MODEL), 0.02),
        'ln1_b': nrm(ks[13], (DEPTH, D_MODEL), 0.02),
        'router_w': nrm(ks[14], (DEPTH, D_MODEL, N_EXPERTS), D_MODEL ** -0.5),
        'router_bias': nrm(ks[15], (DEPTH, N_EXPERTS), 0.01),
        'exp_w_gate': nrm(ks[16], (DEPTH, N_EXPERTS, D_MODEL, EXPERT_FF), D_MODEL ** -0.5),
        'exp_w_up': nrm(ks[17], (DEPTH, N_EXPERTS, D_MODEL, EXPERT_FF), D_MODEL ** -0.5),
        'exp_w_down': nrm(ks[18], (DEPTH, N_EXPERTS, EXPERT_FF, D_MODEL), beta * EXPERT_FF ** -0.5),
        'shared_w_gate': nrm(ks[19], (DEPTH, D_MODEL, EXPERT_FF), D_MODEL ** -0.5),
        'shared_w_up': nrm(ks[20], (DEPTH, D_MODEL, EXPERT_FF), D_MODEL ** -0.5),
        'shared_w_down': nrm(ks[21], (DEPTH, EXPERT_FF, D_MODEL), beta * EXPERT_FF ** -0.5),
        'ln2_w': 1.0 + nrm(ks[22], (DEPTH, D_MODEL), 0.02),
        'ln2_b': nrm(ks[23], (DEPTH, D_MODEL), 0.02),
    }


def reference(x, c, ctx, c_ctx, w_ada, b_ada, w_in, hg_lb_fwd, hg_lb_bwd, hg_norm_w, attn_sink,
              w_out, ln1_w, ln1_b, router_w, router_bias, exp_w_gate, exp_w_up, exp_w_down,
              shared_w_gate, shared_w_up, shared_w_down, ln2_w, ln2_b):
    alpha = (2.0 * DEPTH) ** 0.25
    ang_row, ang_col = rope_2d_angles(x.shape[1])
    lb_fwd = jnp.cumsum(jax.nn.softmax(hg_lb_fwd.astype(jnp.float32), axis=0), axis=0)
    lb_bwd = jnp.cumsum(jax.nn.softmax(hg_lb_bwd.astype(jnp.float32), axis=0), axis=0)
    for layer in range(DEPTH):
        last = layer == DEPTH - 1
        mod = jax.nn.silu(c) @ w_ada[layer] + b_ada[layer]
        sh1, sc1, g1, sh2, sc2, g2 = jnp.split(mod[:, None, :], 6, axis=-1)
        mod_c = jax.nn.silu(c_ctx) @ w_ada[layer] + b_ada[layer]
        csh1, csc1, cg1, csh2, csc2, cg2 = jnp.split(mod_c, 6, axis=-1)
        y_ctx, k_ctx, v_ctx, s_f, s_b = mixer_context(
            modulate(ctx, csh1, csc1), w_in[layer], lb_fwd[layer], lb_bwd[layer],
            hg_norm_w[layer], attn_sink[layer], not last)
        y_lat = mixer_latent(modulate(x, sh1, sc1), w_in[layer], lb_fwd[layer], lb_bwd[layer],
                             hg_norm_w[layer], attn_sink[layer], k_ctx, v_ctx, s_f, s_b,
                             ang_row, ang_col)
        x = layer_norm(alpha * x + g1 * (y_lat @ w_out[layer]), ln1_w[layer], ln1_b[layer])
        ffn = moe(modulate(x, sh2, sc2), router_w[layer], router_bias[layer], exp_w_gate[layer],
                  exp_w_up[layer], exp_w_down[layer], shared_w_gate[layer], shared_w_up[layer],
                  shared_w_down[layer])
        x = layer_norm(alpha * x + g2 * ffn, ln2_w[layer], ln2_b[layer])
        if not last:
            ctx = layer_norm(alpha * ctx + cg1 * (y_ctx @ w_out[layer]), ln1_w[layer], ln1_b[layer])
            ffn_c = moe(modulate(ctx, csh2, csc2), router_w[layer], router_bias[layer],
                        exp_w_gate[layer], exp_w_up[layer], exp_w_down[layer], shared_w_gate[layer],
                        shared_w_up[layer], shared_w_down[layer])
            ctx = layer_norm(alpha * ctx + cg2 * ffn_c, ln2_w[layer], ln2_b[layer])
    return x
```

```cpp
#include <hip/hip_runtime.h>
#include <cstdio>
#include <cstdint>

#define LAS __attribute__((address_space(3)))
#define GAS __attribute__((address_space(1)))
typedef unsigned short bf16;
typedef short bf16x8 __attribute__((ext_vector_type(8)));
typedef short s16x4 __attribute__((ext_vector_type(4)));
typedef float f32x4 __attribute__((ext_vector_type(4)));
typedef float f32x2 __attribute__((ext_vector_type(2)));
typedef unsigned u32x4 __attribute__((ext_vector_type(4)));
typedef unsigned u32x2 __attribute__((ext_vector_type(2)));
typedef GAS unsigned gu32;

constexpr int NB = 16, SEQ = 4096, DM = 1024, CTXL = 256;
constexpr int T = NB * SEQ;
constexpr int TC = NB * CTXL;
constexpr int MALL = T + TC;
constexpr int INC = 3328;
constexpr int C_Q = 0, C_FF = 512, C_FB = 1024, C_I = 1536, C_G = 2048, C_AQ = 2560, C_AK = 3072, C_AV = 3200;
constexpr int NEXP = 64, NE1 = 65, FF = 256;
constexpr float ALPHA = 1.189207115002721f;
constexpr float LOG2E = 1.4426950408889634f;
constexpr float QSCALE = 0.125f * LOG2E;
constexpr int HALF_T = T / 2;
constexpr int HCAP = 311296;
constexpr int HTILES = HCAP / 256;

constexpr size_t MiB = 1u << 20;
constexpr size_t WS_CTL = 0, CTL_ZERO_BYTES = 1 * MiB;
constexpr size_t CTL_MOD = 65536;
constexpr size_t CTL_WGCNT = 524288;
constexpr size_t WS_SMALL = 1 * MiB;
constexpr size_t WS_WIN = 2 * MiB;
constexpr size_t WS_WOUT = 9 * MiB;
constexpr size_t WS_WR = 11 * MiB;
constexpr size_t WS_WGU = 12 * MiB;
constexpr size_t WS_WD = 77 * MiB;
constexpr size_t WS_H = 110 * MiB;
constexpr size_t WS_SEG = 110 * MiB;
constexpr size_t WS_SEGD = 183 * MiB;
constexpr size_t WS_OF = 184 * MiB;
constexpr size_t WS_Z = 250 * MiB;
constexpr size_t WS_Y = 692 * MiB;
constexpr size_t WS_H2 = 110 * MiB;
constexpr size_t WS_RT = 238 * MiB;
constexpr size_t RT_TOKE = 0;
constexpr size_t RT_TOKW = 2 * MiB;
constexpr size_t RT_TOKP = 4 * MiB;
constexpr size_t RT_SLOTTOK = 6 * MiB;
constexpr size_t RT_SLOTW = 9 * MiB;
constexpr size_t WS_ACT = 254 * MiB;
constexpr size_t WS_SO = 406 * MiB;
constexpr size_t WS_END = 1014 * MiB;

constexpr int CW_TMO = 0, CW_CODE = 1, CW_ERR = 2;
constexpr int CW_BAR = 4096;

constexpr int RING_BYTES = 131072;
constexpr int GIDX_OFF = RING_BYTES;
constexpr int GTAB_OFF = RING_BYTES + 2048;
constexpr int MISC_OFF = RING_BYTES + 3072;
constexpr int LDS_BYTES = 163840;

#define RLX_AGENT __ATOMIC_RELAXED, __HIP_MEMORY_SCOPE_AGENT
#define LDS_WAIT() asm volatile("s_waitcnt lgkmcnt(0)" ::: "memory")
#define VM_WAIT() asm volatile("s_waitcnt vmcnt(0)" ::: "memory")
__device__ __forceinline__ unsigned cvt_pk_bf16(float lo, float hi) { unsigned r; asm volatile("v_cvt_pk_bf16_f32 %0, %1, %2" : "=v"(r) : "v"(lo), "v"(hi)); return r; }
__device__ __forceinline__ float bf_lo(unsigned u) { return __uint_as_float(u << 16); }
__device__ __forceinline__ float bf_hi(unsigned u) { return __uint_as_float(u & 0xffff0000u); }
__device__ __forceinline__ float bf2f(bf16 h) { return __uint_as_float((unsigned)h << 16); }
__device__ __forceinline__ bf16 f2bf(float f) { return (bf16)(cvt_pk_bf16(f, 0.f) & 0xffffu); }
__device__ __forceinline__ float wave_sum(float v) {
#pragma unroll
    for (int o = 1; o < 64; o <<= 1) v += __shfl_xor(v, o);
    return v;
}
__device__ __forceinline__ float fast_exp2(float x) { return __builtin_amdgcn_exp2f(x); }
__device__ __forceinline__ float fast_exp(float x) { return __builtin_amdgcn_exp2f(x * LOG2E); }
__device__ __forceinline__ float fast_rcp(float x) { return __builtin_amdgcn_rcpf(x); }
__device__ __forceinline__ float silu_f(float v) { return v * fast_rcp(1.f + fast_exp(-v)); }
#define CAS __attribute__((address_space(4)))
__device__ __forceinline__ const float* IN(int i) { return ((const float* const CAS*)__builtin_amdgcn_kernarg_segment_ptr())[i]; }
__device__ __forceinline__ float* OUT() { return ((float* const CAS*)__builtin_amdgcn_kernarg_segment_ptr())[24]; }
__device__ __forceinline__ unsigned char* WS() { return ((unsigned char* const CAS*)__builtin_amdgcn_kernarg_segment_ptr())[25]; }
struct Ptrs { const float* in[24]; float* out; unsigned char* ws; };
namespace pg8 {
constexpr int BM = 256, BK = 64, HALF = 128, HTB = HALF * BK * 2, STAGE_BYTES = 8 * HTB, NXCD = 8, WGM = 8;
__host__ __device__ __forceinline__ int lds_byte(int r, int c) { const int st = (r >> 4) * 2 + (c >> 5), rr = r & 15, cc = c & 31, ob = rr * 64 + cc * 2; return st * 1024 + (ob ^ (((ob >> 9) & 1) << 5)); }
__host__ __device__ __forceinline__ void stage_rc(int b, int& R, int& C) { const int st = b / 1024, sb = b % 1024, swz = sb ^ (((sb >> 9) & 1) << 5); R = (st >> 1) * 16 + swz / 64; C = (st & 1) * 32 + (swz % 64) / 2; }
__host__ __device__ __forceinline__ int perm32(int rho) { const int n = rho >> 4, i = rho & 15; return 8 * (i >> 2) + 4 * n + (i & 3); }

struct Unit { const char* a; const char* b; const int* gidx; int pm, pn, aux; };

struct DenseOrder {
    const char* A; const char* Bt; int nM, nN, nwg, G, c, K;
    __device__ void init(const void* A_, const void* Bt_, int M, int N, int K_, int G_, int c_) { A = (const char*)A_; Bt = (const char*)Bt_; nM = M / BM; nN = N / BM; nwg = nM * nN; G = G_; c = c_; K = K_; }
    __device__ bool next(int i, Unit& u) const {
        const long L = (long)i * G + c; if (L >= nwg) return false;
        int wgid = (int)L; { const int q = nwg / NXCD, r = nwg % NXCD, xcd = wgid % NXCD, off = wgid / NXCD; wgid = (xcd < r ? xcd * (q + 1) : r * (q + 1) + (xcd - r) * q) + off; }
        const int nig = WGM * nN, gid = wgid / nig, fm = gid * WGM, gsz = (nM - fm) < WGM ? (nM - fm) : WGM;
        u.pm = fm + ((wgid % nig) % gsz); u.pn = (wgid % nig) / gsz; u.aux = 0; u.gidx = nullptr;
        u.a = A + (size_t)u.pm * BM * K * 2; u.b = Bt + (size_t)u.pn * BM * K * 2; return true;
    }
};

template <class Epi, class Sched, bool GATHER>
__device__ __forceinline__ void gemm_phase(LAS unsigned char* lds, LAS unsigned char* gl, const int K, const Sched& S, const Epi& E) {
    int tid_ = threadIdx.x; asm volatile("" : "+v"(tid_));
    const int tid = tid_, wid = __builtin_amdgcn_readfirstlane(tid >> 6), lane = tid & 63, wr = wid >> 2, wc = wid & 3, fr = lane & 15, fq = lane >> 4;
    const int nt = K / BK;
    unsigned voffB[2], vC[2][2];
    const size_t hstep = (size_t)HALF * K * 2;
#pragma unroll
    for (int i = 0; i < 2; ++i) { int R, C; stage_rc(tid * 16 + i * 8192, R, C); const int Rb = (R & ~31) + perm32(R & 31);
        voffB[i] = (unsigned)(Rb * K + C) * 2u;
        vC[0][i] = (unsigned)(R * K + C) * 2u; vC[1][i] = vC[0][i] + (unsigned)hstep; }
    const size_t kstep = (size_t)(BK * 2);
    const unsigned ldsw = (unsigned)wid * 1024u;
    const int aoff = lds_byte(wr * 64 + fr, fq * 8), boff = lds_byte(wc * 32 + fr, fq * 8);
#define PG8_SA(b, h) (((b) * 2 + (h)) * HTB)
#define PG8_SB(b, h) ((4 + (b) * 2 + (h)) * HTB)
#define PG8_STAGE(bufoff, gbase, o0, o1) do { \
        __builtin_amdgcn_global_load_lds((const unsigned*)((const char*)(gbase) + (o0)), (LAS unsigned*)(lds + (bufoff) + ldsw), 16, 0, 0); \
        __builtin_amdgcn_global_load_lds((const unsigned*)((const char*)(gbase) + (o1)), (LAS unsigned*)(lds + (bufoff) + ldsw + 8192), 16, 0, 0); } while (0)
#define PG8_STAGEB(bufoff, gbase) PG8_STAGE(bufoff, gbase, voffB[0], voffB[1])
#define PG8_LDA(dst, b, h) do { _Pragma("unroll") for (int m = 0; m < 4; ++m) _Pragma("unroll") for (int k = 0; k < 2; ++k) dst[m][k] = *(const LAS bf16x8*)(lds + PG8_SA(b, h) + aoff + m * 2048 + k * 1024); } while (0)
#define PG8_LDB(dst, b, h) do { _Pragma("unroll") for (int n = 0; n < 2; ++n) _Pragma("unroll") for (int k = 0; k < 2; ++k) dst[n][k] = *(const LAS bf16x8*)(lds + PG8_SB(b, h) + boff + n * 2048 + k * 1024); } while (0)
#define PG8_MMA(ai, bj, At, Bt) do { __builtin_amdgcn_s_setprio(1); _Pragma("unroll") for (int m = 0; m < 4; ++m) _Pragma("unroll") for (int n = 0; n < 2; ++n) _Pragma("unroll") for (int k = 0; k < 2; ++k) \
        acc[ai][bj][m][n] = __builtin_amdgcn_mfma_f32_16x16x32_bf16(Bt[n][k], At[m][k], acc[ai][bj][m][n], 0, 0, 0); __builtin_amdgcn_s_setprio(0); } while (0)
#define PG8_WAIT_V(n) asm volatile("s_waitcnt vmcnt(" #n ")" ::: "memory")
#define PG8_WAIT_L(n) asm volatile("s_waitcnt lgkmcnt(" #n ")" ::: "memory")
#define PG8_BAR __builtin_amdgcn_s_barrier()
#define PG8_SCHED __builtin_amdgcn_sched_barrier(0)
    Unit cur, nxt; int ui = 0;
    if (!S.next(0, cur)) return;
    f32x4 acc[2][2][4][2];
#pragma unroll
    for (int a = 0; a < 2; ++a)
#pragma unroll
        for (int b = 0; b < 2; ++b)
#pragma unroll
            for (int m = 0; m < 4; ++m)
#pragma unroll
                for (int n = 0; n < 2; ++n) acc[a][b][m][n] = (f32x4){0.f, 0.f, 0.f, 0.f};
    bf16x8 At[4][2], B0[2][2], B1[2][2];
    const char* cA = cur.a; const char* cB = cur.b;
    if constexpr (GATHER) {
#pragma unroll
        for (int h = 0; h < 2; ++h)
#pragma unroll
            for (int i = 0; i < 2; ++i) { int R, C; stage_rc(tid * 16 + i * 8192, R, C); const int r = cur.gidx[h * HALF + R]; vC[h][i] = (unsigned)(r * K + C) * 2u; }
    }
    PG8_STAGEB(PG8_SB(0, 0), cB); PG8_STAGEB(PG8_SB(0, 1), cB + hstep); PG8_STAGE(PG8_SA(0, 0), cA, vC[0][0], vC[0][1]); PG8_STAGE(PG8_SA(0, 1), cA, vC[1][0], vC[1][1]);
    if (wr == 1) PG8_BAR;
    PG8_WAIT_V(2); PG8_BAR;
    PG8_STAGEB(PG8_SB(1, 0), cB + kstep); PG8_STAGE(PG8_SA(1, 0), cA + kstep, vC[0][0], vC[0][1]); PG8_STAGEB(PG8_SB(1, 1), cB + hstep + kstep);
    PG8_WAIT_V(6); PG8_BAR;
    for (;;) {
        const bool has_next = S.next(ui + 1, nxt);
        const char* nA = has_next ? nxt.a : cA; const char* nB = has_next ? nxt.b : cB;
        LAS unsigned char* gln = gl + ((ui + 1) & 1) * 1024;
        if constexpr (GATHER) { if (has_next && wid == 0) __builtin_amdgcn_global_load_lds((const unsigned*)(nxt.gidx + lane * 4), (LAS unsigned*)gln, 16, 0, 0); }
#pragma unroll 1
        for (int t = 0; t < nt; t += 2) {
            const bool last = (t == nt - 2);
            const char* a1 = cA + (size_t)(t + 1) * kstep;
            const char* a2 = last ? nA : cA + (size_t)(t + 2) * kstep; const char* b2 = last ? nB : cB + (size_t)(t + 2) * kstep;
            const char* a3 = a2 + kstep; const char* b3 = b2 + kstep;
            unsigned w00 = vC[0][0], w01 = vC[0][1], w10 = vC[1][0], w11 = vC[1][1];
            if constexpr (GATHER) { if (last && has_next) {
#pragma unroll
                for (int i = 0; i < 2; ++i) { int R, C; stage_rc(tid * 16 + i * 8192, R, C); const int ra = ((const LAS int*)gln)[R], rb = ((const LAS int*)gln)[HALF + R];
                    const unsigned oa = (unsigned)(ra * K + C) * 2u, ob = (unsigned)(rb * K + C) * 2u; if (i == 0) { w00 = oa; w10 = ob; } else { w01 = oa; w11 = ob; } } } }
            PG8_LDB(B0, 0, 0); PG8_LDB(B1, 0, 1); PG8_SCHED; PG8_LDA(At, 0, 0); PG8_STAGE(PG8_SA(1, 1), a1, vC[1][0], vC[1][1]);
            PG8_WAIT_V(8); PG8_WAIT_L(0); PG8_BAR; PG8_MMA(0, 0, At, B0); PG8_MMA(0, 1, At, B1); PG8_BAR; PG8_SCHED;
            PG8_LDA(At, 0, 1); PG8_STAGEB(PG8_SB(0, 0), b2); PG8_STAGEB(PG8_SB(0, 1), b2 + hstep); PG8_STAGE(PG8_SA(0, 0), a2, w00, w01);
            PG8_WAIT_V(8); PG8_WAIT_L(0); PG8_BAR; PG8_MMA(1, 0, At, B0); PG8_MMA(1, 1, At, B1); PG8_BAR; PG8_SCHED;
            PG8_LDB(B0, 1, 0); PG8_LDB(B1, 1, 1); PG8_SCHED; PG8_LDA(At, 1, 0); PG8_STAGE(PG8_SA(0, 1), a2, w10, w11);
            PG8_WAIT_V(8); PG8_WAIT_L(0); PG8_BAR; PG8_MMA(0, 0, At, B0); PG8_MMA(0, 1, At, B1); PG8_BAR; PG8_SCHED;
            PG8_LDA(At, 1, 1); PG8_STAGEB(PG8_SB(1, 0), b3); PG8_STAGEB(PG8_SB(1, 1), b3 + hstep); PG8_STAGE(PG8_SA(1, 0), a3, w00, w01);
            PG8_WAIT_V(8); PG8_WAIT_L(0); PG8_BAR; PG8_MMA(1, 0, At, B0); PG8_MMA(1, 1, At, B1); PG8_BAR; PG8_SCHED;
        }
        if (wr == 0) PG8_BAR;
        E(acc, cur, wr, wc, fr, fq);
        if (!has_next) break;
#pragma unroll
        for (int a = 0; a < 2; ++a)
#pragma unroll
            for (int b = 0; b < 2; ++b)
#pragma unroll
                for (int m = 0; m < 4; ++m)
#pragma unroll
                    for (int n = 0; n < 2; ++n) acc[a][b][m][n] = (f32x4){0.f, 0.f, 0.f, 0.f};
        cur = nxt; cA = nA; cB = nB; ++ui;
        if constexpr (GATHER) {
#pragma unroll
            for (int i = 0; i < 2; ++i) { int R, C; stage_rc(tid * 16 + i * 8192, R, C); const int ra = ((const LAS int*)gln)[R], rb = ((const LAS int*)gln)[HALF + R];
                vC[0][i] = (unsigned)(ra * K + C) * 2u; vC[1][i] = (unsigned)(rb * K + C) * 2u; } }
        if (wr == 1) PG8_BAR;
    }
    PG8_WAIT_V(0);
    PG8_BAR;
#undef PG8_SA
#undef PG8_SB
#undef PG8_STAGE
#undef PG8_STAGEB
#undef PG8_LDA
#undef PG8_LDB
#undef PG8_MMA
#undef PG8_WAIT_V
#undef PG8_WAIT_L
#undef PG8_BAR
#undef PG8_SCHED
}
}
#define XB_TMO      128
#define XB_XCNT(j)  (256  + 64 * (j))
#define XB_XSUB(j)  (1280 + 64 * (j))
#define XB_XGEN(j)  (2304 + 64 * (j))
#define XB_TOP      3328
#define XB_TOPGEN   3392
#define XCD_BAR_WORDS 3456
#define XB_SPIN_CAP (1u << 18)

__device__ __forceinline__ unsigned xb_ld(unsigned* p)              { return __hip_atomic_load(p, __ATOMIC_RELAXED, __HIP_MEMORY_SCOPE_AGENT); }
__device__ __forceinline__ unsigned xb_add(unsigned* p, unsigned v) { return __hip_atomic_fetch_add(p, v, __ATOMIC_RELAXED, __HIP_MEMORY_SCOPE_AGENT); }
__device__ __forceinline__ unsigned xb_xcc_id() { return (unsigned)__builtin_amdgcn_s_getreg((3 << 11) | 20) & 0xFu; }
#define XB_SPIN(cond, bar) do { unsigned _sp = 0; while (cond) { __builtin_amdgcn_s_sleep(1); \
    if ((++_sp & 255u) == 0u) { if (xb_ld(&(bar)[XB_TMO])) break; if (_sp > XB_SPIN_CAP) { atomicAdd(&(bar)[XB_TMO], 1u); break; } } } } while (0)

struct XcdBarrier {
    unsigned* bar; unsigned x;
    volatile LAS unsigned* st;
};

__device__ __forceinline__ XcdBarrier xcd_barrier_post(unsigned* bar, volatile LAS unsigned* st) {
    XcdBarrier b; b.bar = bar; b.x = xb_xcc_id(); b.st = st;
    if (threadIdx.x == 0) (void)xb_add(&bar[XB_XCNT(b.x)], 1u);
    return b;
}
__device__ __forceinline__ void xcd_barrier_complete(unsigned* bar, unsigned x, unsigned& nloc, unsigned& nx) {
    const unsigned G = gridDim.x * gridDim.y * gridDim.z;
    unsigned sum, cnt, mine, sp = 0u;
    for (;;) {
        sum = 0u; cnt = 0u; mine = 0u;
#pragma unroll
        for (unsigned j = 0; j < 16; ++j) { const unsigned c = xb_ld(&bar[XB_XCNT(j)]); sum += c; cnt += (c > 0u) ? 1u : 0u; mine = (j == x) ? c : mine; }
        if (sum == G) break;
        __builtin_amdgcn_s_sleep(1);
        if ((++sp & 255u) == 0u) { if (xb_ld(&bar[XB_TMO])) break; if (sp > XB_SPIN_CAP) { atomicAdd(&bar[XB_TMO], 1u); break; } }
    }
    nloc = mine > 0u ? mine : 1u; nx = cnt > 0u ? cnt : 1u;
}

__device__ __forceinline__ void xcd_barrier(const XcdBarrier& b) {
    asm volatile("s_waitcnt vmcnt(0)" ::: "memory");
    __syncthreads();
    if (threadIdx.x == 0) {
        unsigned* bar = b.bar;
        __builtin_amdgcn_s_waitcnt(0);
        unsigned nloc = b.st[0], nx = b.st[1];
        if (nloc == 0u) { xcd_barrier_complete(bar, b.x, nloc, nx); b.st[0] = nloc; b.st[1] = nx; }
        const unsigned old = xb_add(&bar[XB_XSUB(b.x)], 1u);
        const unsigned gen = old / nloc;
        if (old + 1u == (gen + 1u) * nloc) {
            __builtin_amdgcn_fence(__ATOMIC_RELEASE, "agent");
            asm volatile("s_waitcnt vmcnt(0)" ::: "memory");
            const unsigned og = xb_add(&bar[XB_TOP], 1u);
            const unsigned tg = og / nx;
            if (og + 1u == (tg + 1u) * nx) xb_add(&bar[XB_TOPGEN], 1u);
            else XB_SPIN(xb_ld(&bar[XB_TOPGEN]) == tg, bar);
            __builtin_amdgcn_fence(__ATOMIC_ACQUIRE, "agent");
            xb_add(&bar[XB_XGEN(b.x)], 1u);
            asm volatile("s_waitcnt vmcnt(0)" ::: "memory");
        } else {
            XB_SPIN(xb_ld(&bar[XB_XGEN(b.x)]) == gen, bar);
            __builtin_amdgcn_fence(__ATOMIC_ACQUIRE, "agent");
            asm volatile("s_waitcnt vmcnt(0)" ::: "memory");
        }
    }
    __syncthreads();
}
__device__ __forceinline__ void p0_transpose_item(const float* W, int K, int N, bf16* WT, bf16* WTlo, int mode, LAS float* scr, int item, int lane) {
    const int nblk = N / 32, kb = item / nblk, nb = item % nblk, k0 = 64 * kb, n0 = 32 * nb;
#pragma unroll 8
    for (int i = 0; i < 32; ++i) { const int kk = 2 * i + (lane >> 5); scr[kk * 33 + (lane & 31)] = W[(size_t)(k0 + kk) * N + n0 + (lane & 31)]; }
    LDS_WAIT(); asm volatile("" ::: "memory");
    const int rowbase = (mode == 0) ? n0 : ((n0 >> 7) * 256 + (n0 & 127) + (mode == 2 ? 128 : 0));
    const int c = lane & 7;
#pragma unroll
    for (int j = 0; j < 4; ++j) { const int n = (lane >> 3) + 8 * j; const LAS float* s = scr + (8 * c) * 33 + n;
        float v[8];
#pragma unroll
        for (int q = 0; q < 8; ++q) v[q] = s[q * 33];
        u32x4 o; o.x = cvt_pk_bf16(v[0], v[1]); o.y = cvt_pk_bf16(v[2], v[3]); o.z = cvt_pk_bf16(v[4], v[5]); o.w = cvt_pk_bf16(v[6], v[7]);
        *(GAS u32x4*)(WT + (size_t)(rowbase + n) * K + k0 + 8 * c) = o;
        if (WTlo) { u32x4 l; l.x = cvt_pk_bf16(v[0] - bf_lo(o.x), v[1] - bf_hi(o.x)); l.y = cvt_pk_bf16(v[2] - bf_lo(o.y), v[3] - bf_hi(o.y));
            l.z = cvt_pk_bf16(v[4] - bf_lo(o.z), v[5] - bf_hi(o.z)); l.w = cvt_pk_bf16(v[6] - bf_lo(o.w), v[7] - bf_hi(o.w));
            *(GAS u32x4*)(WTlo + (size_t)(rowbase + n) * K + k0 + 8 * c) = l; } }
    LDS_WAIT(); asm volatile("" ::: "memory");
}
__device__ __forceinline__ void p0_mod_task(const float* c, const float* c_ctx, const float* w_ada, const float* b_ada, float* mod, LAS float* scr, int task, int lane) {
    const int cg = task % 24, kc = task / 24, k0 = kc * 128, j0 = cg * 256 + lane * 4;
    for (int idx = lane; idx < 17 * 128; idx += 64) { const int r = idx >> 7, kk = idx & 127; const float v = (r < 16) ? c[r * DM + k0 + kk] : c_ctx[k0 + kk]; scr[idx] = v / (1.f + expf(-v)); }
    LDS_WAIT(); asm volatile("" ::: "memory");
    f32x4 acc[17];
#pragma unroll
    for (int r = 0; r < 17; ++r) acc[r] = (f32x4){0.f, 0.f, 0.f, 0.f};
#pragma unroll 4
    for (int kk = 0; kk < 128; ++kk) { const f32x4 w = *(const GAS f32x4*)(w_ada + (size_t)(k0 + kk) * 6144 + j0);
#pragma unroll
        for (int r = 0; r < 17; ++r) acc[r] += w * scr[r * 128 + kk]; }
    if (kc == 0) { const f32x4 b = *(const GAS f32x4*)(b_ada + j0);
#pragma unroll
        for (int r = 0; r < 17; ++r) acc[r] += b; }
#pragma unroll
    for (int r = 0; r < 17; ++r) { float* d = mod + r * 6144 + j0; atomicAdd(d, acc[r].x); atomicAdd(d + 1, acc[r].y); atomicAdd(d + 2, acc[r].z); atomicAdd(d + 3, acc[r].w); }
    LDS_WAIT(); asm volatile("" ::: "memory");
}


__device__ __forceinline__ void p0_prologue(LAS unsigned char* lds, int vcu, int G, int wave, int lane) {
    LAS float* scr = (LAS float*)(lds + wave * 16384);
    unsigned char* ws = WS();
    if (wave == 0 && (int)blockIdx.x < 192) p0_mod_task(IN(1), IN(3), IN(4), IN(5), (float*)(ws + WS_CTL + CTL_MOD), scr, (int)blockIdx.x, lane);
    if (wave == 0 && (int)blockIdx.x == 200) {
        float* LB = (float*)(ws + WS_SMALL);
        for (int d = lane; d < 512; d += 64) { LB[d] = 1.f / (1.f + expf(IN(7)[512 + d] - IN(7)[d])); LB[512 + d] = 1.f / (1.f + expf(IN(8)[512 + d] - IN(8)[d])); }
    }
    if (wave == 0 && (int)blockIdx.x == 201) {
        f32x2* RT = (f32x2*)(ws + WS_SMALL + 4096);
        for (int e = lane; e < 1024; e += 64) { const int pos = e >> 4, i = e & 15; const double fr = pow(10000.0, -(double)i / 16.0), a = (double)pos * fr; RT[e] = (f32x2){(float)cos(a), (float)sin(a)}; }
    }
    const int gw = vcu * 8 + wave, NGW = G * 8;
    constexpr int I_IN = 16 * 104, I_OUT = 16 * 32, I_E = 128, I_R = 32;
    constexpr int NITEMS = I_IN + I_OUT + NE1 * 3 * I_E + I_R;
    for (int it = gw; it < NITEMS; it += NGW) {
        int r = it;
        if (r < I_IN) { p0_transpose_item(IN(6), DM, INC, (bf16*)(ws + WS_WIN), nullptr, 0, scr, r, lane); continue; } r -= I_IN;
        if (r < I_OUT) { p0_transpose_item(IN(11), DM, DM, (bf16*)(ws + WS_WOUT), nullptr, 0, scr, r, lane); continue; } r -= I_OUT;
        if (r < NE1 * 3 * I_E) { const int e = r / (3 * I_E), q = r % (3 * I_E), typ = q / I_E, item = q % I_E;
            if (typ < 2) { const float* src = (e < NEXP) ? IN(16 + typ) + (size_t)e * DM * FF : IN(19 + typ);
                p0_transpose_item(src, DM, FF, (bf16*)(ws + WS_WGU) + (size_t)e * 512 * DM, nullptr, 1 + typ, scr, item, lane); }
            else { const float* src = (e < NEXP) ? IN(18) + (size_t)e * FF * DM : IN(21);
                p0_transpose_item(src, FF, DM, (bf16*)(ws + WS_WD) + (size_t)e * DM * FF, nullptr, 0, scr, item, lane); }
            continue; } r -= NE1 * 3 * I_E;
        p0_transpose_item(IN(14), DM, NEXP, (bf16*)(ws + WS_WR), (bf16*)(ws + WS_WR) + NEXP * DM, 0, scr, r, lane);
    }
}

__device__ __forceinline__ void p1_modulate(int vcu, int G, int wave, int lane) {
    const float* mod = (const float*)(WS() + WS_CTL + CTL_MOD); bf16* H = (bf16*)(WS() + WS_H);
    const int gw = vcu * 8 + wave, NGW = G * 8, per = (MALL + NGW - 1) / NGW;
    int r0 = gw * per, r1 = r0 + per; if (r1 > MALL) r1 = MALL;
    int curb = -1; f32x4 sh[4], sc[4];
    for (int r = r0; r < r1; ++r) {
        const int b = (r < T) ? (r >> 12) : 16;
        if (b != curb) { curb = b;
#pragma unroll
            for (int j = 0; j < 4; ++j) { sh[j] = *(const GAS f32x4*)(mod + b * 6144 + 4 * lane + 256 * j); sc[j] = *(const GAS f32x4*)(mod + b * 6144 + 1024 + 4 * lane + 256 * j) + 1.f; } }
        const float* src = (r < T) ? IN(0) + (size_t)r * DM : IN(2) + (size_t)(r - T) * DM;
        f32x4 v[4]; float s = 0.f;
#pragma unroll
        for (int j = 0; j < 4; ++j) { v[j] = *(const GAS f32x4*)(src + 4 * lane + 256 * j); s += (v[j].x + v[j].y) + (v[j].z + v[j].w); }
        const float mean = wave_sum(s) * (1.f / DM); float s2 = 0.f;
#pragma unroll
        for (int j = 0; j < 4; ++j) { v[j] = v[j] - mean; s2 += (v[j].x * v[j].x + v[j].y * v[j].y) + (v[j].z * v[j].z + v[j].w * v[j].w); }
        const float rstd = 1.f / sqrtf(wave_sum(s2) * (1.f / DM) + 1e-6f);
        bf16* o = H + (size_t)r * DM;
#pragma unroll
        for (int j = 0; j < 4; ++j) { const f32x4 y = v[j] * rstd * sc[j] + sh[j]; u32x2 w; w.x = cvt_pk_bf16(y.x, y.y); w.y = cvt_pk_bf16(y.z, y.w); *(GAS u32x2*)(o + 4 * lane + 256 * j) = w; }
    }
}

typedef f32x4 acc_t[2][2][4][2];
struct EpiZ {
    bf16* Z; const float* LB; const f32x2* RT;
    __device__ __forceinline__ void operator()(const acc_t& acc, const pg8::Unit& u, int wr, int wc, int fr, int fq) const {
        const int row0 = u.pm * 256 + wr * 64 + fr, pn = u.pn, cb = wc * 32 + 8 * fq;
        const bool latent = u.pm < T / 256;
#pragma unroll
        for (int bj = 0; bj < 2; ++bj) {
            const int col = pn * 256 + bj * 128 + cb;
            const bool gate = (pn >= 2 && pn <= 5);
            const bool rope = latent && (pn == 10 || pn == 11 || (pn == 12 && bj == 0));
            const bool isq = (pn == 10 || pn == 11);
            f32x4 l0 = (f32x4){0.f, 0.f, 0.f, 0.f}, l1 = l0;
            if (gate) { const float* lb = LB + (col - C_FF); l0 = *(const GAS f32x4*)lb; l1 = *(const GAS f32x4*)(lb + 4); }
#pragma unroll
            for (int ai = 0; ai < 2; ++ai)
#pragma unroll
                for (int m = 0; m < 4; ++m) {
                    const int row = row0 + ai * 128 + m * 16;
                    f32x4 v0 = acc[ai][bj][m][0], v1 = acc[ai][bj][m][1];
                    if (gate) {
#pragma unroll
                        for (int j = 0; j < 4; ++j) { const float s0 = fast_rcp(1.f + fast_exp(-v0[j])), s1 = fast_rcp(1.f + fast_exp(-v1[j]));
                            v0[j] = __logf(l0[j] + (1.f - l0[j]) * s0); v1[j] = __logf(l1[j] + (1.f - l1[j]) * s1); }
                    } else if (rope) {
                        const int n = row & (SEQ - 1), pos = (wc & 1) ? (n & 63) : (n >> 6);
                        const f32x4* cs = (const f32x4*)(RT + pos * 16 + 8 * (fq & 1));
                        const f32x4 c0 = cs[0], c1 = cs[1], c2 = cs[2], c3 = cs[3];
                        const float sg = (fq & 2) ? 1.f : -1.f;
                        f32x4 o0, o1;
#pragma unroll
                        for (int j = 0; j < 4; ++j) { o0[j] = __shfl_xor(v0[j], 32); o1[j] = __shfl_xor(v1[j], 32); }
                        v0[0] = v0[0] * c0[0] + sg * o0[0] * c0[1]; v0[1] = v0[1] * c0[2] + sg * o0[1] * c0[3];
                        v0[2] = v0[2] * c1[0] + sg * o0[2] * c1[1]; v0[3] = v0[3] * c1[2] + sg * o0[3] * c1[3];
                        v1[0] = v1[0] * c2[0] + sg * o1[0] * c2[1]; v1[1] = v1[1] * c2[2] + sg * o1[1] * c2[3];
                        v1[2] = v1[2] * c3[0] + sg * o1[2] * c3[1]; v1[3] = v1[3] * c3[2] + sg * o1[3] * c3[3];
                    }
                    if (isq) { v0 = v0 * QSCALE; v1 = v1 * QSCALE; }
                    u32x4 w; w.x = cvt_pk_bf16(v0[0], v0[1]); w.y = cvt_pk_bf16(v0[2], v0[3]); w.z = cvt_pk_bf16(v1[0], v1[1]); w.w = cvt_pk_bf16(v1[2], v1[3]);
                    *(GAS u32x4*)(Z + (size_t)row * INC + col) = w;
                }
        }
    }
};
struct EpiR1 {
    const float* x; const float* mod; float* out;
    __device__ __forceinline__ void operator()(const acc_t& acc, const pg8::Unit& u, int wr, int wc, int fr, int fq) const {
        const int row0 = u.pm * 256 + wr * 64 + fr, b = (u.pm * 256) >> 12;
#pragma unroll
        for (int bj = 0; bj < 2; ++bj) {
            const int col = u.pn * 256 + bj * 128 + wc * 32 + 8 * fq;
            const f32x4 g0 = *(const GAS f32x4*)(mod + b * 6144 + 2048 + col), g1 = *(const GAS f32x4*)(mod + b * 6144 + 2048 + col + 4);
#pragma unroll
            for (int ai = 0; ai < 2; ++ai)
#pragma unroll
                for (int m = 0; m < 4; ++m) { const size_t off = (size_t)(row0 + ai * 128 + m * 16) * DM + col;
                    const f32x4 x0 = *(const GAS f32x4*)(x + off), x1 = *(const GAS f32x4*)(x + off + 4);
                    *(GAS f32x4*)(out + off) = x0 * ALPHA + g0 * acc[ai][bj][m][0]; *(GAS f32x4*)(out + off + 4) = x1 * ALPHA + g1 * acc[ai][bj][m][1]; }
        }
    }
};
__device__ __forceinline__ s16x4 ds_tr(const LAS unsigned char* p) { return __builtin_bit_cast(s16x4, __builtin_amdgcn_ds_read_tr16_b64_v4i16((LAS s16x4*)p)); }
#define MFMA16(a, b, c) __builtin_amdgcn_mfma_f32_16x16x32_bf16((a), (b), (c), 0, 0, 0)
constexpr int AP = 144;
__device__ __forceinline__ void attn_phase(LAS unsigned char* lds, int vcu, int G) {
    const bf16* Z = (const bf16*)(WS() + WS_Z); bf16* Y = (bf16*)(WS() + WS_Y); const float* sink = IN(10);
    int tid_ = threadIdx.x; asm volatile("" : "+v"(tid_)); const int tid = tid_, wid = __builtin_amdgcn_readfirstlane(tid >> 6), lane = tid & 63, fr = lane & 15, fq = lane >> 4;
    LAS unsigned char* Ks = lds; LAS unsigned char* Vs = lds + 64 * AP;
    const int lkey = tid >> 3, lch = tid & 7;
    for (int u = vcu; u < NB * 32 * 2; u += G) {
        const int b = u >> 6, band = (u >> 1) & 31, kvh = u & 1, qh = kvh * 4 + (wid >> 1), i0 = (wid & 1) * 64;
        const int twlo = (band == 0) ? 2 : 0, twhi = (band == 31) ? 3 : 5, ntile = 4 + (twhi - twlo + 1);
        bf16x8 qf[4][2];
#pragma unroll
        for (int qt = 0; qt < 4; ++qt)
#pragma unroll
            for (int ks = 0; ks < 2; ++ks) qf[qt][ks] = *(const GAS bf16x8*)(Z + (size_t)(b * SEQ + band * 128 + i0 + qt * 16 + fr) * INC + C_AQ + qh * 64 + ks * 32 + fq * 8);
        float mrun[4], lrun[4]; f32x4 o[4][4];
        const float m0 = sink[qh] * LOG2E;
#pragma unroll
        for (int qt = 0; qt < 4; ++qt) { mrun[qt] = m0; lrun[qt] = (fq == 0) ? 1.f : 0.f;
#pragma unroll
            for (int dt = 0; dt < 4; ++dt) o[dt][qt] = (f32x4){0.f, 0.f, 0.f, 0.f}; }
        u32x4 kreg, vreg;
        { const size_t row = (size_t)(T + b * CTXL + lkey); kreg = *(const GAS u32x4*)(Z + row * INC + C_AK + kvh * 64 + lch * 8); vreg = *(const GAS u32x4*)(Z + row * INC + C_AV + kvh * 64 + lch * 8); }
        for (int n = 0; n < ntile; ++n) {
            __syncthreads();
            *(LAS u32x4*)(Ks + lkey * AP + lch * 16) = kreg; *(LAS u32x4*)(Vs + lkey * AP + lch * 16) = vreg;
            __syncthreads();
            if (n + 1 < ntile) { const int nn = n + 1; const size_t row = (nn < 4) ? (size_t)(T + b * CTXL + nn * 64 + lkey) : (size_t)(b * SEQ + band * 128 - 128 + (twlo + nn - 4) * 64 + lkey);
                kreg = *(const GAS u32x4*)(Z + row * INC + C_AK + kvh * 64 + lch * 8); vreg = *(const GAS u32x4*)(Z + row * INC + C_AV + kvh * 64 + lch * 8); }
            const int tw = (n < 4) ? -1 : (twlo + n - 4);
            bool need = true, mask = false;
            if (tw >= 0) { need = (tw * 64 + 63 >= i0) && (tw * 64 <= i0 + 63 + 256); mask = !((tw * 64 >= i0 + 63) && (tw * 64 + 63 <= i0 + 256)); }
            if (!need) continue;
#pragma unroll
            for (int qt = 0; qt < 4; ++qt) {
                f32x4 s[4];
#pragma unroll
                for (int kt = 0; kt < 4; ++kt) { s[kt] = (f32x4){0.f, 0.f, 0.f, 0.f};
#pragma unroll
                    for (int ks = 0; ks < 2; ++ks) { const bf16x8 kf = *(const LAS bf16x8*)(Ks + (kt * 16 + fr) * AP + ks * 64 + fq * 16); s[kt] = MFMA16(kf, qf[qt][ks], s[kt]); } }
                if (mask) { const int i = i0 + qt * 16 + fr;
#pragma unroll
                    for (int kt = 0; kt < 4; ++kt)
#pragma unroll
                        for (int r = 0; r < 4; ++r) { const int j = tw * 64 + kt * 16 + fq * 4 + r; if (!(j >= i && j <= i + 256)) s[kt][r] = -INFINITY; } }
                float tm = fmaxf(fmaxf(s[0][0], s[0][1]), fmaxf(s[0][2], s[0][3]));
#pragma unroll
                for (int kt = 1; kt < 4; ++kt) tm = fmaxf(tm, fmaxf(fmaxf(s[kt][0], s[kt][1]), fmaxf(s[kt][2], s[kt][3])));
                tm = fmaxf(tm, __shfl_xor(tm, 16)); tm = fmaxf(tm, __shfl_xor(tm, 32));
                const float mn = fmaxf(mrun[qt], tm), sc = fast_exp2(mrun[qt] - mn); mrun[qt] = mn;
                float ps = 0.f;
#pragma unroll
                for (int kt = 0; kt < 4; ++kt)
#pragma unroll
                    for (int r = 0; r < 4; ++r) { s[kt][r] = fast_exp2(s[kt][r] - mn); ps += s[kt][r]; }
                lrun[qt] = lrun[qt] * sc + ps;
                bf16x8 pf[2];
#pragma unroll
                for (int k2 = 0; k2 < 2; ++k2) { u32x4 w; w.x = cvt_pk_bf16(s[2 * k2][0], s[2 * k2][1]); w.y = cvt_pk_bf16(s[2 * k2][2], s[2 * k2][3]); w.z = cvt_pk_bf16(s[2 * k2 + 1][0], s[2 * k2 + 1][1]); w.w = cvt_pk_bf16(s[2 * k2 + 1][2], s[2 * k2 + 1][3]); pf[k2] = __builtin_bit_cast(bf16x8, w); }
#pragma unroll
                for (int dt = 0; dt < 4; ++dt) { f32x4 a = o[dt][qt] * sc;
#pragma unroll
                    for (int k2 = 0; k2 < 2; ++k2) { const LAS unsigned char* vp = Vs + (k2 * 32 + fq * 4 + (fr >> 2)) * AP + dt * 32 + (fr & 3) * 8;
                        const s16x4 lo = ds_tr(vp), hi = ds_tr(vp + 16 * AP);
                        const bf16x8 vf = (bf16x8){lo[0], lo[1], lo[2], lo[3], hi[0], hi[1], hi[2], hi[3]};
                        a = MFMA16(vf, pf[k2], a); }
                    o[dt][qt] = a; }
            }
        }
#pragma unroll
        for (int qt = 0; qt < 4; ++qt) { float l = lrun[qt]; l += __shfl_xor(l, 16); l += __shfl_xor(l, 32); const float rl = 1.f / l;
            bf16* yp = Y + (size_t)(b * SEQ + band * 128 + i0 + qt * 16 + fr) * DM + 512 + qh * 64 + fq * 4;
#pragma unroll
            for (int dt = 0; dt < 4; ++dt) { const f32x4 a = o[dt][qt] * rl; u32x2 w; w.x = cvt_pk_bf16(a[0], a[1]); w.y = cvt_pk_bf16(a[2], a[3]); *(GAS u32x2*)(yp + dt * 16) = w; } }
    }
    __syncthreads();
}
constexpr int HP = 272;
constexpr int L_KH0 = 0, L_KH1 = 16 * HP, L_KH2 = 48 * HP, L_KH3 = 96 * HP;
constexpr int L_QH = 160 * HP;
constexpr int L_KE = L_QH + 64 * HP;
constexpr int L_V = L_KE + 64 * HP;
constexpr int L_ST = L_V + 64 * HP;
constexpr int L_ATT = L_ST + 128 * HP;
constexpr int L_TOT = L_ATT + 8 * 16 * 144;
constexpr int L_FQ = L_TOT + 2048;
constexpr int L_DEC = L_FQ + 2048;
constexpr int L_SS = L_DEC + 512;
static_assert(L_SS + 512 <= LDS_BYTES - 256, "HGRN LDS map");

struct HgrnChain { const bf16* Z; int rowbase; int h; int dir; };

template <bool WITH_OUT>
struct HgrnStep {
    unsigned greg[16], qreg[16]; u32x4 vreg[2];
    __device__ __forceinline__ void prefetch(const HgrnChain& c, int c0, int wid, int lane, int tid) {
        const int n = wid & 3, role = wid >> 2;
        const int gcol = (c.dir ? C_FB : C_FF) + c.h * 128 + 2 * lane, qcol = C_Q + c.h * 128 + 2 * lane;
#pragma unroll
        for (int t = 0; t < 16; ++t) { const int p = 16 * n + t, tk = c.dir ? (c0 + 63 - p) : (c0 + p); const bf16* rp = c.Z + (size_t)(c.rowbase + tk) * INC;
            greg[t] = *(const GAS unsigned*)(rp + gcol); if (WITH_OUT && role == 1) qreg[t] = *(const GAS unsigned*)(rp + qcol); }
#pragma unroll
        for (int i = 0; i < 2; ++i) { const int idx = tid + 512 * i, p = idx >> 4, ch = idx & 15, tk = c.dir ? (c0 + 63 - p) : (c0 + p);
            vreg[i] = *(const GAS u32x4*)(c.Z + (size_t)(c.rowbase + tk) * INC + C_I + c.h * 128 + ch * 8); }
    }
};

template <bool WITH_OUT>
__device__ __forceinline__ void hgrn_chunk(LAS unsigned char* lds, HgrnStep<WITH_OUT>& pf, f32x4 (&st)[8], f32x4 (&oacc)[4], float (&segsum)[2],
                                           const HgrnChain& c, int next_c0, bool has_next, int wid, int lane, int tid) {
    const int n = wid & 3, role = wid >> 2, fr = lane & 15, fq = lane >> 4, d0 = 2 * lane;
    LAS float* TOT = (LAS float*)(lds + L_TOT); LAS float* FQ = (LAS float*)(lds + L_FQ); LAS float* DEC = (LAS float*)(lds + L_DEC);
    float gl0[16], gl1[16], cs0[16], cs1[16];
    { float a0 = 0.f, a1 = 0.f;
#pragma unroll
      for (int t = 0; t < 16; ++t) { gl0[t] = bf_lo(pf.greg[t]); gl1[t] = bf_hi(pf.greg[t]); a0 += fmaxf(gl0[t], -4.f); a1 += fmaxf(gl1[t], -4.f); cs0[t] = a0; cs1[t] = a1; } }
    if (role == 0) *(LAS f32x2*)(TOT + n * 128 + d0) = (f32x2){cs0[15], cs1[15]};
#pragma unroll
    for (int i = 0; i < 2; ++i) { const int idx = tid + 512 * i, p = idx >> 4, ch = idx & 15; *(LAS u32x4*)(lds + L_V + p * HP + ch * 16) = pf.vreg[i]; }
    __syncthreads();
    float R0[5], R1[5];
    { R0[0] = 0.f; R1[0] = 0.f;
#pragma unroll
      for (int q = 0; q < 4; ++q) { const f32x2 tt = *(const LAS f32x2*)(TOT + q * 128 + d0); R0[q + 1] = R0[q] + tt.x; R1[q + 1] = R1[q] + tt.y; } }
    if (role == 0) {
        const float tot0 = cs0[15], tot1 = cs1[15];
        const float eD0 = fast_exp(-tot0), eD1 = fast_exp(-tot1);
        const float eE0 = fast_exp(R0[4] - R0[n + 1]), eE1 = fast_exp(R1[4] - R1[n + 1]);
        float eH0[4], eH1[4];
#pragma unroll
        for (int q = 0; q < 4; ++q) { eH0[q] = fast_exp(R0[q] - R0[n + 1]); eH1[q] = fast_exp(R1[q] - R1[n + 1]); }
#pragma unroll
        for (int t = 0; t < 16; ++t) {
            const float k0 = 1.f - fast_exp(gl0[t]), k1 = 1.f - fast_exp(gl1[t]);
            const float ke0 = k0 * fast_exp(tot0 - cs0[t]), ke1 = k1 * fast_exp(tot1 - cs1[t]);
            const int rowoff = (16 * n + t) * HP + d0 * 2;
            *(LAS unsigned*)(lds + L_KE + rowoff) = cvt_pk_bf16(ke0 * eE0, ke1 * eE1);
            if (WITH_OUT) {
                const int khb = (n == 0) ? L_KH0 : (n == 1) ? L_KH1 : (n == 2) ? L_KH2 : L_KH3;
                *(LAS unsigned*)(lds + khb + rowoff) = cvt_pk_bf16(ke0 * eD0, ke1 * eD1);
                if (n < 1) *(LAS unsigned*)(lds + L_KH1 + rowoff) = cvt_pk_bf16(ke0 * eH0[1], ke1 * eH1[1]);
                if (n < 2) *(LAS unsigned*)(lds + L_KH2 + rowoff) = cvt_pk_bf16(ke0 * eH0[2], ke1 * eH1[2]);
                if (n < 3) *(LAS unsigned*)(lds + L_KH3 + rowoff) = cvt_pk_bf16(ke0 * eH0[3], ke1 * eH1[3]);
            }
        }
        if (WITH_OUT) *(LAS f32x2*)(FQ + n * 128 + d0) = (f32x2){fast_exp(R0[n]), fast_exp(R1[n])};
        if (n == 3) { *(LAS f32x2*)(DEC + d0) = (f32x2){fast_exp(R0[4]), fast_exp(R1[4])}; segsum[0] += R0[4]; segsum[1] += R1[4]; }
    } else if (WITH_OUT) {
#pragma unroll
        for (int t = 0; t < 16; ++t) { const float q0 = bf_lo(pf.qreg[t]) * fast_exp(cs0[t]), q1 = bf_hi(pf.qreg[t]) * fast_exp(cs1[t]);
            *(LAS unsigned*)(lds + L_QH + (16 * n + t) * HP + d0 * 2) = cvt_pk_bf16(q0, q1); }
    }
    __syncthreads();
    if (has_next) pf.prefetch(c, next_c0, wid, lane, tid);
    if (WITH_OUT) {
        const int eh = wid >> 2;
        LAS unsigned char* ATT = lds + L_ATT + wid * (16 * 144);
        bf16x8 aq[4];
#pragma unroll
        for (int ks = 0; ks < 4; ++ks) aq[ks] = *(const LAS bf16x8*)(lds + L_QH + (16 * n + fr) * HP + ks * 64 + fq * 16);
        const int khb = (n == 0) ? L_KH0 : (n == 1) ? L_KH1 : (n == 2) ? L_KH2 : L_KH3;
#pragma unroll
        for (int m = 0; m < 4; ++m) {
            if (m <= n) { f32x4 a = (f32x4){0.f, 0.f, 0.f, 0.f};
#pragma unroll
                for (int ks = 0; ks < 4; ++ks) { const bf16x8 bk = *(const LAS bf16x8*)(lds + khb + (16 * m + fr) * HP + ks * 64 + fq * 16); a = MFMA16(aq[ks], bk, a); }
#pragma unroll
                for (int r = 0; r < 4; ++r) { float v = a[r]; if (m == n && fr > fq * 4 + r) v = 0.f; *(LAS bf16*)(ATT + (fq * 4 + r) * 144 + (16 * m + fr) * 2) = f2bf(v); } }
            else if (m == n + 1 && (n & 1) == 0) {
#pragma unroll
                for (int r = 0; r < 4; ++r) *(LAS bf16*)(ATT + (fq * 4 + r) * 144 + (16 * m + fr) * 2) = 0; }
        }
        bf16x8 qt[4];
#pragma unroll
        for (int ks = 0; ks < 4; ++ks) { const f32x4 f0 = *(const LAS f32x4*)(FQ + n * 128 + ks * 32 + fq * 8), f1 = *(const LAS f32x4*)(FQ + n * 128 + ks * 32 + fq * 8 + 4);
            const u32x4 w = __builtin_bit_cast(u32x4, aq[ks]); u32x4 o;
            o.x = cvt_pk_bf16(bf_lo(w.x) * f0[0], bf_hi(w.x) * f0[1]); o.y = cvt_pk_bf16(bf_lo(w.y) * f0[2], bf_hi(w.y) * f0[3]);
            o.z = cvt_pk_bf16(bf_lo(w.z) * f1[0], bf_hi(w.z) * f1[1]); o.w = cvt_pk_bf16(bf_lo(w.w) * f1[2], bf_hi(w.w) * f1[3]); qt[ks] = __builtin_bit_cast(bf16x8, o); }
        bf16x8 pa[2];
        pa[0] = *(const LAS bf16x8*)(ATT + fr * 144 + fq * 16); pa[1] = *(const LAS bf16x8*)(ATT + fr * 144 + 64 + fq * 16);
#pragma unroll
        for (int et = 0; et < 4; ++et) { const int eb = 4 * eh + et; f32x4 a = (f32x4){0.f, 0.f, 0.f, 0.f};
#pragma unroll
            for (int k2 = 0; k2 < 2; ++k2) { if (k2 <= (n >> 1)) { const LAS unsigned char* vp = lds + L_V + (32 * k2 + 8 * fq + (fr >> 2)) * HP + eb * 32 + (fr & 3) * 8;
                const s16x4 lo = ds_tr(vp), hi = ds_tr(vp + 4 * HP); const bf16x8 bv = (bf16x8){lo[0], lo[1], lo[2], lo[3], hi[0], hi[1], hi[2], hi[3]}; a = MFMA16(pa[k2], bv, a); } }
#pragma unroll
            for (int ks = 0; ks < 4; ++ks) { const bf16x8 bs = *(const LAS bf16x8*)(lds + L_ST + (eb * 16 + fr) * HP + ks * 64 + fq * 16); a = MFMA16(qt[ks], bs, a); }
            oacc[et] = a; }
    }
    {
        const f32x4 dec = *(const LAS f32x4*)(DEC + 16 * wid + 4 * fq);
        bf16x8 ak[2];
#pragma unroll
        for (int k2 = 0; k2 < 2; ++k2) { const LAS unsigned char* kp = lds + L_KE + (32 * k2 + 8 * fq + (fr >> 2)) * HP + wid * 32 + (fr & 3) * 8;
            const s16x4 lo = ds_tr(kp), hi = ds_tr(kp + 4 * HP); ak[k2] = (bf16x8){lo[0], lo[1], lo[2], lo[3], hi[0], hi[1], hi[2], hi[3]}; }
#pragma unroll
        for (int eb = 0; eb < 8; ++eb) { f32x4 a = st[eb] * dec;
#pragma unroll
            for (int k2 = 0; k2 < 2; ++k2) { const LAS unsigned char* vp = lds + L_V + (32 * k2 + 8 * fq + (fr >> 2)) * HP + eb * 32 + (fr & 3) * 8;
                const s16x4 lo = ds_tr(vp), hi = ds_tr(vp + 4 * HP); const bf16x8 bv = (bf16x8){lo[0], lo[1], lo[2], lo[3], hi[0], hi[1], hi[2], hi[3]}; a = MFMA16(ak[k2], bv, a); }
            st[eb] = a; }
    }
    __syncthreads();
    if (WITH_OUT) {
#pragma unroll
        for (int eb = 0; eb < 8; ++eb) { u32x2 w; w.x = cvt_pk_bf16(st[eb][0], st[eb][1]); w.y = cvt_pk_bf16(st[eb][2], st[eb][3]); *(LAS u32x2*)(lds + L_ST + (eb * 16 + fr) * HP + (16 * wid + 4 * fq) * 2) = w; }
    }
}

__device__ __forceinline__ void hgrn_state_init(f32x4 (&st)[8], const float* SEG, const float* SEGD, int chain, int slot_first, int slot_step, int nslots_latent, int wid, int lane) {
    const int fr = lane & 15, fq = lane >> 4;
#pragma unroll
    for (int eb = 0; eb < 8; ++eb) st[eb] = (f32x4){0.f, 0.f, 0.f, 0.f};
    f32x4 Pd = (f32x4){1.f, 1.f, 1.f, 1.f};
    int slot = slot_first;
    for (int it = 0; it <= nslots_latent; ++it) {
        const int sl = (it < nslots_latent) ? slot : 0;
        const float* X = SEG + ((size_t)chain * 9 + sl) * 16384 + (size_t)(16 * wid + 4 * fq) * 128 + fr;
#pragma unroll
        for (int eb = 0; eb < 8; ++eb)
#pragma unroll
            for (int r = 0; r < 4; ++r) st[eb][r] += Pd[r] * X[r * 128 + eb * 16];
        const f32x4 dd = *(const GAS f32x4*)(SEGD + ((size_t)chain * 9 + sl) * 128 + 16 * wid + 4 * fq);
        Pd = Pd * dd;
        const bool live = (Pd[0] != 0.f) || (Pd[1] != 0.f) || (Pd[2] != 0.f) || (Pd[3] != 0.f);
        if (!__any(live)) break;
        slot += slot_step;
    }
}

__device__ __forceinline__ void hgrn_pass_a(LAS unsigned char* lds, int vcu, int G) {
    const bf16* Z = (const bf16*)(WS() + WS_Z); float* SEG = (float*)(WS() + WS_SEG); float* SEGD = (float*)(WS() + WS_SEGD);
    int tid_ = threadIdx.x; asm volatile("" : "+v"(tid_)); const int tid = tid_, wid = __builtin_amdgcn_readfirstlane(tid >> 6), lane = tid & 63, fr = lane & 15, fq = lane >> 4;
    for (int u = vcu; u < 1152; u += G) {
        int b, h, dir, slot, nch, tok0;
        if (u < 1024) { b = u >> 6; h = (u >> 4) & 3; dir = (u >> 3) & 1; const int s = u & 7; slot = 1 + s; nch = 8; tok0 = s * 512; }
        else { const int v = u - 1024; b = v >> 3; h = (v >> 1) & 3; dir = v & 1; slot = 0; nch = 4; tok0 = 0; }
        HgrnChain c{Z, (slot == 0) ? (T + b * CTXL) : (b * SEQ), h, dir};
        const int chain = (b * 4 + h) * 2 + dir;
        f32x4 st[8], oacc[4]; float segsum[2] = {0.f, 0.f};
#pragma unroll
        for (int eb = 0; eb < 8; ++eb) st[eb] = (f32x4){0.f, 0.f, 0.f, 0.f};
        HgrnStep<false> pf;
        pf.prefetch(c, dir ? (tok0 + (nch - 1) * 64) : tok0, wid, lane, tid);
        for (int k = 0; k < nch; ++k) { const int kn = k + 1, nc0 = tok0 + (dir ? (nch - 1 - kn) : kn) * 64;
            hgrn_chunk<false>(lds, pf, st, oacc, segsum, c, nc0, kn < nch, wid, lane, tid); }
        float* X = SEG + ((size_t)chain * 9 + slot) * 16384 + (size_t)(16 * wid + 4 * fq) * 128 + fr;
#pragma unroll
        for (int eb = 0; eb < 8; ++eb)
#pragma unroll
            for (int r = 0; r < 4; ++r) X[r * 128 + eb * 16] = st[eb][r];
        if (wid == 3) *(GAS f32x2*)(SEGD + ((size_t)chain * 9 + slot) * 128 + 2 * lane) = (f32x2){expf(segsum[0]), expf(segsum[1])};
        __syncthreads();
    }
}

__device__ __forceinline__ void hgrn_pass_c(LAS unsigned char* lds, int vcu, int G) {
    const bf16* Z = (const bf16*)(WS() + WS_Z); const float* SEG = (const float*)(WS() + WS_SEG); const float* SEGD = (const float*)(WS() + WS_SEGD);
    float* OF = (float*)(WS() + WS_OF) + (size_t)blockIdx.x * 512 * 128; bf16* Y = (bf16*)(WS() + WS_Y); const float* nw = IN(9);
    int tid_ = threadIdx.x; asm volatile("" : "+v"(tid_)); const int tid = tid_, wid = __builtin_amdgcn_readfirstlane(tid >> 6), lane = tid & 63, fr = lane & 15, fq = lane >> 4, n = wid & 3, eh = wid >> 2;
    LAS float* SS = (LAS float*)(lds + L_SS);
    for (int u = vcu; u < 512; u += G) {
        const int b = u >> 5, h = (u >> 3) & 3, s = u & 7, tok0 = s * 512;
        for (int dir = 0; dir < 2; ++dir) {
            HgrnChain c{Z, b * SEQ, h, dir};
            const int chain = (b * 4 + h) * 2 + dir;
            f32x4 st[8], oacc[4]; float segsum[2] = {0.f, 0.f};
            if (dir == 0) hgrn_state_init(st, SEG, SEGD, chain, s, -1, s, wid, lane);
            else hgrn_state_init(st, SEG, SEGD, chain, s + 2, 1, 7 - s, wid, lane);
#pragma unroll
            for (int eb = 0; eb < 8; ++eb) { u32x2 w; w.x = cvt_pk_bf16(st[eb][0], st[eb][1]); w.y = cvt_pk_bf16(st[eb][2], st[eb][3]); *(LAS u32x2*)(lds + L_ST + (eb * 16 + fr) * HP + (16 * wid + 4 * fq) * 2) = w; }
            HgrnStep<true> pf;
            pf.prefetch(c, dir ? (tok0 + 7 * 64) : tok0, wid, lane, tid);
            for (int k = 0; k < 8; ++k) { const int kn = k + 1, c0 = tok0 + (dir ? (7 - k) : k) * 64, nc0 = tok0 + (dir ? (7 - kn) : kn) * 64;
                hgrn_chunk<true>(lds, pf, st, oacc, segsum, c, nc0, kn < 8, wid, lane, tid);
                if (dir == 0) {
#pragma unroll
                    for (int et = 0; et < 4; ++et)
#pragma unroll
                        for (int r = 0; r < 4; ++r) { const int p = 16 * n + 4 * fq + r; OF[(size_t)(c0 - tok0 + p) * 128 + 16 * (4 * eh + et) + fr] = oacc[et][r]; }
                } else {
                    float ss[4] = {0.f, 0.f, 0.f, 0.f};
#pragma unroll
                    for (int et = 0; et < 4; ++et)
#pragma unroll
                        for (int r = 0; r < 4; ++r) { const int p = 16 * n + 4 * fq + r, tl = c0 - tok0 + 63 - p;
                            const float of = __hip_atomic_load(OF + (size_t)tl * 128 + 16 * (4 * eh + et) + fr, RLX_AGENT); oacc[et][r] += of; ss[r] += oacc[et][r] * oacc[et][r]; }
#pragma unroll
                    for (int r = 0; r < 4; ++r) { float v = ss[r]; v += __shfl_xor(v, 1); v += __shfl_xor(v, 2); v += __shfl_xor(v, 4); v += __shfl_xor(v, 8); if (fr == 0) SS[eh * 64 + 16 * n + 4 * fq + r] = v; }
                    __syncthreads();
#pragma unroll
                    for (int r = 0; r < 4; ++r) { const int p = 16 * n + 4 * fq + r, tk = c0 + 63 - p; const float rinv = 1.f / sqrtf((SS[p] + SS[64 + p]) * (1.f / 128.f) + 1e-6f);
                        const size_t row = (size_t)(b * SEQ + tk);
#pragma unroll
                        for (int et = 0; et < 4; ++et) { const int e = h * 128 + 16 * (4 * eh + et) + fr; const float zg = bf2f(Z[row * INC + C_G + e]);
                            Y[row * DM + e] = f2bf(oacc[et][r] * rinv * nw[e] * silu_f(zg)); } }
                }
            }
            VM_WAIT(); __syncthreads();
        }
    }
}
__device__ __forceinline__ void p6_ln1(int vcu, int G, int wave, int lane) {
    const float* mod = (const float*)(WS() + WS_CTL + CTL_MOD); bf16* H2 = (bf16*)(WS() + WS_H2); float* X1 = OUT();
    const int gw = vcu * 8 + wave, NGW = G * 8, per = (T + NGW - 1) / NGW;
    int r0 = gw * per, r1 = r0 + per; if (r1 > T) r1 = T;
    f32x4 lw[4], lb[4];
#pragma unroll
    for (int j = 0; j < 4; ++j) { lw[j] = *(const GAS f32x4*)(IN(12) + 4 * lane + 256 * j); lb[j] = *(const GAS f32x4*)(IN(13) + 4 * lane + 256 * j); }
    int curb = -1; f32x4 sh[4], sc[4];
    for (int r = r0; r < r1; ++r) {
        const int b = r >> 12;
        if (b != curb) { curb = b;
#pragma unroll
            for (int j = 0; j < 4; ++j) { sh[j] = *(const GAS f32x4*)(mod + b * 6144 + 3072 + 4 * lane + 256 * j); sc[j] = *(const GAS f32x4*)(mod + b * 6144 + 4096 + 4 * lane + 256 * j) + 1.f; } }
        float* xr = X1 + (size_t)r * DM;
        f32x4 v[4]; float s = 0.f;
#pragma unroll
        for (int j = 0; j < 4; ++j) { v[j] = *(const GAS f32x4*)(xr + 4 * lane + 256 * j); s += (v[j].x + v[j].y) + (v[j].z + v[j].w); }
        float mean = wave_sum(s) * (1.f / DM), s2 = 0.f;
#pragma unroll
        for (int j = 0; j < 4; ++j) { v[j] = v[j] - mean; s2 += (v[j].x * v[j].x + v[j].y * v[j].y) + (v[j].z * v[j].z + v[j].w * v[j].w); }
        float rstd = 1.f / sqrtf(wave_sum(s2) * (1.f / DM) + 1e-5f);
        s = 0.f;
#pragma unroll
        for (int j = 0; j < 4; ++j) { v[j] = v[j] * rstd * lw[j] + lb[j]; *(GAS f32x4*)(xr + 4 * lane + 256 * j) = v[j]; s += (v[j].x + v[j].y) + (v[j].z + v[j].w); }
        mean = wave_sum(s) * (1.f / DM); s2 = 0.f;
#pragma unroll
        for (int j = 0; j < 4; ++j) { v[j] = v[j] - mean; s2 += (v[j].x * v[j].x + v[j].y * v[j].y) + (v[j].z * v[j].z + v[j].w * v[j].w); }
        rstd = 1.f / sqrtf(wave_sum(s2) * (1.f / DM) + 1e-6f);
        bf16* o = H2 + (size_t)r * DM;
#pragma unroll
        for (int j = 0; j < 4; ++j) { const f32x4 y = v[j] * rstd * sc[j] + sh[j]; u32x2 w; w.x = cvt_pk_bf16(y.x, y.y); w.y = cvt_pk_bf16(y.z, y.w); *(GAS u32x2*)(o + 4 * lane + 256 * j) = w; }
    }
}

__device__ __forceinline__ float wave_max(float v) {
#pragma unroll
    for (int o = 1; o < 64; o <<= 1) v = fmaxf(v, __shfl_xor(v, o));
    return v;
}
__device__ __forceinline__ void p7_route(LAS unsigned char* lds, int vcu, int wave, int lane) {
    const bf16* H2 = (const bf16*)(WS() + WS_H2); const bf16* WR = (const bf16*)(WS() + WS_WR);
    int* TOKE = (int*)(WS() + WS_RT + RT_TOKE); float* TOKW = (float*)(WS() + WS_RT + RT_TOKW); int* TOKP = (int*)(WS() + WS_RT + RT_TOKP);
    unsigned* WGCNT = (unsigned*)(WS() + WS_CTL + CTL_WGCNT);
    LAS float* LG = (LAS float*)(lds + wave * 16384);
    LAS unsigned* CNT = (LAS unsigned*)(lds + 8 * 16384);
    int tid_ = threadIdx.x; asm volatile("" : "+v"(tid_)); const int tid = tid_, fr = lane & 15, fq = lane >> 4;
    if (tid < 64) CNT[tid] = 0u;
    __syncthreads();
    const int r0 = vcu * 256 + wave * 32;
    f32x4 acc[2][4];
#pragma unroll
    for (int t = 0; t < 2; ++t)
#pragma unroll
        for (int et = 0; et < 4; ++et) acc[t][et] = (f32x4){0.f, 0.f, 0.f, 0.f};
#pragma unroll 2
    for (int ks = 0; ks < 32; ++ks) {
        bf16x8 a[2], bh[4], bl[4];
#pragma unroll
        for (int t = 0; t < 2; ++t) a[t] = *(const GAS bf16x8*)(H2 + (size_t)(r0 + t * 16 + fr) * DM + ks * 32 + fq * 8);
#pragma unroll
        for (int et = 0; et < 4; ++et) { bh[et] = *(const GAS bf16x8*)(WR + (size_t)(et * 16 + fr) * DM + ks * 32 + fq * 8); bl[et] = *(const GAS bf16x8*)(WR + (size_t)(NEXP + et * 16 + fr) * DM + ks * 32 + fq * 8); }
#pragma unroll
        for (int t = 0; t < 2; ++t)
#pragma unroll
            for (int et = 0; et < 4; ++et) { acc[t][et] = MFMA16(a[t], bh[et], acc[t][et]); acc[t][et] = MFMA16(a[t], bl[et], acc[t][et]); }
    }
#pragma unroll
    for (int t = 0; t < 2; ++t)
#pragma unroll
        for (int et = 0; et < 4; ++et)
#pragma unroll
            for (int r = 0; r < 4; ++r) LG[(t * 16 + 4 * fq + r) * 65 + et * 16 + fr] = acc[t][et][r];
    LDS_WAIT(); asm volatile("" ::: "memory");
    const float bias = IN(15)[lane];
    const int g = lane >> 3;
    for (int rr = 0; rr < 32; ++rr) {
        const int t = r0 + rr;
        const float logit = LG[rr * 65 + lane];
        const float score = 1.f / (1.f + expf(-logit)), sel = score + bias;
        float m1 = sel; m1 = fmaxf(m1, __shfl_xor(m1, 1)); m1 = fmaxf(m1, __shfl_xor(m1, 2)); m1 = fmaxf(m1, __shfl_xor(m1, 4));
        const unsigned long long bm = __ballot(sel == m1);
        const unsigned gb = (unsigned)(bm >> (8 * g)) & 0xffu; const int first = __builtin_ctz(gb);
        float m2 = ((lane & 7) == first) ? -INFINITY : sel; m2 = fmaxf(m2, __shfl_xor(m2, 1)); m2 = fmaxf(m2, __shfl_xor(m2, 2)); m2 = fmaxf(m2, __shfl_xor(m2, 4));
        const float gs = m1 + m2;
        int cnt = 0;
#pragma unroll
        for (int q = 0; q < 8; ++q) { const float v = __shfl(gs, 8 * q); cnt += (v > gs || (v == gs && q < g)) ? 1 : 0; }
        float masked = (cnt < 4) ? sel : -INFINITY;
        bool chosen = false;
#pragma unroll
        for (int k = 0; k < 8; ++k) { const float mx = wave_max(masked); const unsigned long long bb = __ballot(masked == mx); const int idx = __builtin_ctzll(bb); if (lane == idx) { chosen = true; masked = -INFINITY; } }
        const unsigned long long cm = __ballot(chosen);
        const float wsum = wave_sum(chosen ? score : 0.f);
        if (chosen) { const int kpos = __builtin_popcountll(cm & ((1ull << lane) - 1ull));
            const unsigned rank = atomicAdd((unsigned*)&CNT[lane], 1u);
            TOKE[t * 8 + kpos] = lane; TOKW[t * 8 + kpos] = score / wsum * 2.5f; TOKP[t * 8 + kpos] = (int)rank; }
    }
    __syncthreads();
    if (tid < 64) WGCNT[vcu * 64 + tid] = CNT[tid];
}

__device__ __forceinline__ void p8_scatter(LAS unsigned char* lds, int vcu, int wave, int lane) {
    int* TOKE = (int*)(WS() + WS_RT + RT_TOKE); float* TOKW = (float*)(WS() + WS_RT + RT_TOKW); int* TOKP = (int*)(WS() + WS_RT + RT_TOKP);
    int* SLOTTOK = (int*)(WS() + WS_RT + RT_SLOTTOK); float* SLOTW = (float*)(WS() + WS_RT + RT_SLOTW);
    const unsigned* WGCNT = (const unsigned*)(WS() + WS_CTL + CTL_WGCNT); int* GOFF = (int*)(WS() + WS_SMALL + 16384);
    LAS int* TOTL = (LAS int*)lds; LAS int* PRE = TOTL + 128; LAS int* GO = PRE + 128;
    int tid_ = threadIdx.x; asm volatile("" : "+v"(tid_)); const int tid = tid_, myh = vcu >> 7;
    if (tid < 128) { const int h = tid >> 6, e = tid & 63; int tot = 0, pre = 0;
        for (int w = 0; w < 128; ++w) { const int c = (int)WGCNT[(h * 128 + w) * 64 + e]; tot += c; if (h == myh && (h * 128 + w) < vcu) pre += c; }
        TOTL[tid] = tot; if (h == myh) PRE[e] = pre; }
    __syncthreads();
    if (tid < 2) { int off = 0; for (int e = 0; e < 64; ++e) { GO[tid * 66 + e] = off; off += (TOTL[tid * 64 + e] + 255) & ~255; } GO[tid * 66 + 64] = off; GO[tid * 66 + 65] = off + HALF_T; }
    __syncthreads();
    if (vcu == 0) {
        if (tid < 132) GOFF[tid] = GO[tid];
        if (tid < 128) { const int h = tid >> 6, e = tid & 63; const int beg = GO[h * 66 + e] + TOTL[tid], end = GO[h * 66 + e + 1];
            for (int s = beg; s < end; ++s) { SLOTTOK[h * HCAP + s] = h * HALF_T; SLOTW[h * HCAP + s] = 0.f; } }
    }
    const int r0 = vcu * 256 + wave * 32;
    for (int rr = 0; rr < 32; ++rr) { const int t = r0 + rr;
        if (lane < 8) { const int e = TOKE[t * 8 + lane]; const int slot = GO[myh * 66 + e] + PRE[e] + TOKP[t * 8 + lane];
            SLOTTOK[myh * HCAP + slot] = t; SLOTW[myh * HCAP + slot] = TOKW[t * 8 + lane]; TOKP[t * 8 + lane] = slot; }
        if (lane == 8) { const int slot = GO[myh * 66 + 64] + (t - myh * HALF_T); SLOTTOK[myh * HCAP + slot] = t; SLOTW[myh * HCAP + slot] = 1.f; }
    }
    __syncthreads();
}

template <int NN  , bool GATHER>
struct GroupedOrder {
    const LAS int* GT; const char* A; const char* B; const int* sl; int G, c, K; size_t bgroup;
    __device__ void init(LAS int* gt, const int* goff_h, const void* A_, const void* B_, const int* slottok_h, int K_, size_t bgroup_bytes, int G_, int c_) {
        if (threadIdx.x == 0) { int cum = 0; for (int e = 0; e < NE1; ++e) { gt[e] = cum; cum += ((goff_h[e + 1] - goff_h[e]) >> 8) * NN; gt[66 + e] = goff_h[e]; } gt[NE1] = cum; }
        __syncthreads();
        GT = gt; A = (const char*)A_; B = (const char*)B_; sl = slottok_h; G = G_; c = c_; K = K_; bgroup = bgroup_bytes;
    }
    __device__ bool next(int i, pg8::Unit& u) const {
#define RFL(x) __builtin_amdgcn_readfirstlane(x)
        const int L = i * G + c; if (L >= RFL(GT[NE1])) return false;
        int e = 0; while (RFL(GT[e + 1]) <= L) ++e;
        const int g0 = RFL(GT[e]), g1 = RFL(GT[e + 1]), ro = RFL(GT[66 + e]);
        const int local = L - g0, ntile = (g1 - g0) / NN, nt = local / ntile, mt = local - nt * ntile;
        u.pm = (ro >> 8) + mt; u.pn = nt; u.aux = e;
#undef RFL
        u.b = B + (size_t)e * bgroup + (size_t)nt * 256 * K * 2;
        if (GATHER) { u.a = A; u.gidx = sl + u.pm * 256; } else { u.a = A + (size_t)u.pm * 256 * K * 2; u.gidx = nullptr; }
        return true;
    }
};
struct EpiAct {
    bf16* ACT;
    __device__ __forceinline__ void operator()(const acc_t& acc, const pg8::Unit& u, int wr, int wc, int fr, int fq) const {
        const int row0 = u.pm * 256 + wr * 64 + fr, col = u.pn * 128 + wc * 32 + 8 * fq;
#pragma unroll
        for (int ai = 0; ai < 2; ++ai)
#pragma unroll
            for (int m = 0; m < 4; ++m) { float o[8];
#pragma unroll
                for (int n = 0; n < 2; ++n)
#pragma unroll
                    for (int j = 0; j < 4; ++j) { const float gte = acc[ai][0][m][n][j]; o[4 * n + j] = gte * fast_rcp(1.f + fast_exp(-gte)) * acc[ai][1][m][n][j]; }
                u32x4 w; w.x = cvt_pk_bf16(o[0], o[1]); w.y = cvt_pk_bf16(o[2], o[3]); w.z = cvt_pk_bf16(o[4], o[5]); w.w = cvt_pk_bf16(o[6], o[7]);
                *(GAS u32x4*)(ACT + (size_t)(row0 + ai * 128 + m * 16) * FF + col) = w; }
    }
};
struct EpiDown {
    bf16* SO; const float* SW;
    __device__ __forceinline__ void operator()(const acc_t& acc, const pg8::Unit& u, int wr, int wc, int fr, int fq) const {
        const int row0 = u.pm * 256 + wr * 64 + fr;
#pragma unroll
        for (int ai = 0; ai < 2; ++ai)
#pragma unroll
            for (int m = 0; m < 4; ++m) { const int row = row0 + ai * 128 + m * 16; const float g = SW[row];
#pragma unroll
                for (int bj = 0; bj < 2; ++bj) { const f32x4 v0 = acc[ai][bj][m][0] * g, v1 = acc[ai][bj][m][1] * g;
                    u32x4 w; w.x = cvt_pk_bf16(v0[0], v0[1]); w.y = cvt_pk_bf16(v0[2], v0[3]); w.z = cvt_pk_bf16(v1[0], v1[1]); w.w = cvt_pk_bf16(v1[2], v1[3]);
                    *(GAS u32x4*)(SO + (size_t)row * DM + u.pn * 256 + bj * 128 + wc * 32 + 8 * fq) = w; } }
    }
};

__device__ __forceinline__ void p11_combine(int half, int vcu, int G, int wave, int lane) {
    const float* mod = (const float*)(WS() + WS_CTL + CTL_MOD); const bf16* SO = (const bf16*)(WS() + WS_SO);
    const int* TOKP = (const int*)(WS() + WS_RT + RT_TOKP); const int* GOFF = (const int*)(WS() + WS_SMALL + 16384);
    float* X1 = OUT();
    const int gw = vcu * 8 + wave, NGW = G * 8, per = (HALF_T + NGW - 1) / NGW;
    int r0 = gw * per, r1 = r0 + per; if (r1 > HALF_T) r1 = HALF_T;
    const int shbase = GOFF[half * 66 + 64];
    f32x4 lw[4], lb[4], g2[4]; int curb = -1;
#pragma unroll
    for (int j = 0; j < 4; ++j) { const int col = 8 * lane + 512 * (j >> 1) + 4 * (j & 1); lw[j] = *(const GAS f32x4*)(IN(22) + col); lb[j] = *(const GAS f32x4*)(IN(23) + col); }
    for (int r = r0; r < r1; ++r) {
        const int t = half * HALF_T + r, b = t >> 12;
        if (b != curb) { curb = b;
#pragma unroll
            for (int j = 0; j < 4; ++j) g2[j] = *(const GAS f32x4*)(mod + b * 6144 + 5120 + 8 * lane + 512 * (j >> 1) + 4 * (j & 1)); }
        int slot = (lane < 8) ? TOKP[t * 8 + lane] : (shbase + r);
        f32x4 y[4];
#pragma unroll
        for (int j = 0; j < 4; ++j) y[j] = (f32x4){0.f, 0.f, 0.f, 0.f};
#pragma unroll
        for (int k = 0; k < 9; ++k) { const int sk = __shfl(slot, k); const bf16* sp = SO + (size_t)sk * DM + 8 * lane;
            const u32x4 a = *(const GAS u32x4*)sp, c = *(const GAS u32x4*)(sp + 512);
            y[0] += (f32x4){bf_lo(a.x), bf_hi(a.x), bf_lo(a.y), bf_hi(a.y)}; y[1] += (f32x4){bf_lo(a.z), bf_hi(a.z), bf_lo(a.w), bf_hi(a.w)};
            y[2] += (f32x4){bf_lo(c.x), bf_hi(c.x), bf_lo(c.y), bf_hi(c.y)}; y[3] += (f32x4){bf_lo(c.z), bf_hi(c.z), bf_lo(c.w), bf_hi(c.w)}; }
        float* xr = X1 + (size_t)t * DM; f32x4 v[4]; float s = 0.f;
#pragma unroll
        for (int j = 0; j < 4; ++j) { const int col = 8 * lane + 512 * (j >> 1) + 4 * (j & 1); v[j] = *(const GAS f32x4*)(xr + col) * ALPHA + g2[j] * y[j]; s += (v[j].x + v[j].y) + (v[j].z + v[j].w); }
        const float mean = wave_sum(s) * (1.f / DM); float s2 = 0.f;
#pragma unroll
        for (int j = 0; j < 4; ++j) { v[j] = v[j] - mean; s2 += (v[j].x * v[j].x + v[j].y * v[j].y) + (v[j].z * v[j].z + v[j].w * v[j].w); }
        const float rstd = 1.f / sqrtf(wave_sum(s2) * (1.f / DM) + 1e-5f);
#pragma unroll
        for (int j = 0; j < 4; ++j) { const int col = 8 * lane + 512 * (j >> 1) + 4 * (j & 1); *(GAS f32x4*)(xr + col) = v[j] * rstd * lw[j] + lb[j]; }
    }
}
#ifndef PHMASK
#define PHMASK 0xffffffffu
#endif
#define PH(k) ((PHMASK >> (k)) & 1u)
__global__ void __launch_bounds__(512, 2) mk_fwd(Ptrs P) {
    extern __shared__ __attribute__((aligned(16))) unsigned char lds_raw[];
    LAS unsigned char* lds = (LAS unsigned char*)lds_raw;
    const int tid = threadIdx.x, lane = tid & 63, wave = __builtin_amdgcn_readfirstlane(tid >> 6);
    const int G = gridDim.x; const int bx = blockIdx.x; const int vcu = (G % 8 == 0) ? (bx % 8) * (G / 8) + bx / 8 : bx;
    volatile LAS unsigned* MISC = (volatile LAS unsigned*)(lds + LDS_BYTES - 256);
    if (tid < 64) MISC[tid] = 0u;
    __syncthreads();
    unsigned char* ws = WS();
    gu32* ctl = (gu32*)(ws + WS_CTL);
    XcdBarrier bar = xcd_barrier_post((unsigned*)(ctl + CW_BAR), MISC + 8);
(void)bar;
#define GRID_BAR() do { XcdBarrier b_; b_.bar = (unsigned*)(WS() + WS_CTL) + CW_BAR; b_.x = (unsigned)__builtin_amdgcn_readfirstlane((int)xb_xcc_id()); b_.st = (volatile LAS unsigned*)(lds + LDS_BYTES - 256) + 8; xcd_barrier(b_); } while (0)

    if (PH(0)) p0_prologue(lds, vcu, G, wave, lane);
    GRID_BAR();
    if (PH(1)) p1_modulate(vcu, G, wave, lane);
    GRID_BAR();
    if (PH(2)) { pg8::DenseOrder S; S.init(ws + WS_H, ws + WS_WIN, MALL, INC, DM, G, bx);
      EpiZ E{(bf16*)(ws + WS_Z), (const float*)(ws + WS_SMALL), (const f32x2*)(ws + WS_SMALL + 4096)};
      pg8::gemm_phase<EpiZ, pg8::DenseOrder, false>(lds, lds + GIDX_OFF, DM, S, E); }
    GRID_BAR();
    if (PH(3)) attn_phase(lds, vcu, G);
    if (PH(4)) hgrn_pass_a(lds, vcu, G);
    GRID_BAR();
    if (PH(5)) hgrn_pass_c(lds, vcu, G);
    GRID_BAR();
    if (PH(6)) { pg8::DenseOrder S; S.init(ws + WS_Y, ws + WS_WOUT, T, DM, DM, G, bx);
      EpiR1 E{IN(0), (const float*)(ws + WS_CTL + CTL_MOD), OUT()};
      pg8::gemm_phase<EpiR1, pg8::DenseOrder, false>(lds, lds + GIDX_OFF, DM, S, E); }
    GRID_BAR();
    if (PH(7)) p6_ln1(vcu, G, wave, lane);
    GRID_BAR();
    if (PH(8)) p7_route(lds, vcu, wave, lane);
    GRID_BAR();
    if (PH(9)) p8_scatter(lds, vcu, wave, lane);
    GRID_BAR();
#pragma unroll
    for (int half = 0; half < 2; ++half) {
        const int* goff_h = (const int*)(ws + WS_SMALL + 16384) + half * 66;
        const int* sl_h = (const int*)(ws + WS_RT + RT_SLOTTOK) + half * HCAP;
        if (PH(10)) { GroupedOrder<2, true> S; S.init((LAS int*)(lds + GTAB_OFF), goff_h, ws + WS_H2, ws + WS_WGU, sl_h, DM, (size_t)512 * DM * 2, G, bx);
          EpiAct E{(bf16*)(ws + WS_ACT)};
          pg8::gemm_phase<EpiAct, GroupedOrder<2, true>, true>(lds, lds + GIDX_OFF, DM, S, E); }
        GRID_BAR();
        if (PH(11)) { GroupedOrder<4, false> S; S.init((LAS int*)(lds + GTAB_OFF), goff_h, ws + WS_ACT, ws + WS_WD, sl_h, FF, (size_t)DM * FF * 2, G, bx);
          EpiDown E{(bf16*)(ws + WS_SO), (const float*)(ws + WS_RT + RT_SLOTW) + half * HCAP};
          pg8::gemm_phase<EpiDown, GroupedOrder<4, false>, false>(lds, lds + GIDX_OFF, FF, S, E); }
        GRID_BAR();
        if (PH(12)) p11_combine(half, vcu, G, wave, lane);
    }
}

extern "C" void kernel_launch(void* const* d_in, const int* in_sizes, int n_in, void* d_out, int out_size, void* d_ws, size_t ws_size, hipStream_t stream) {
    static int ready = 0;
    if (ready == 0) {
        if (n_in != 24 || in_sizes[0] != T * DM || out_size != T * DM || ws_size < WS_END) { fprintf(stderr, "kernel_launch: unexpected problem shape (n_in %d, in0 %d, out %d, ws %zu); nothing launched\n", n_in, n_in > 0 ? in_sizes[0] : -1, out_size, ws_size); ready = -1; return; }
        if (hipFuncSetAttribute((const void*)mk_fwd, hipFuncAttributeMaxDynamicSharedMemorySize, LDS_BYTES) != hipSuccess) { fprintf(stderr, "kernel_launch: hipFuncSetAttribute failed\n"); ready = -1; return; }
        int per_cu = 0;
        if (hipOccupancyMaxActiveBlocksPerMultiprocessor(&per_cu, (const void*)mk_fwd, 512, LDS_BYTES) != hipSuccess || per_cu < 1) fprintf(stderr, "kernel_launch: note: occupancy query reports %d workgroups per CU\n", per_cu);
        (void)hipGetLastError();
        ready = 1;
    }
    if (ready < 0) return;
    if (hipMemsetAsync((char*)d_ws + WS_CTL, 0, CTL_ZERO_BYTES, stream) != hipSuccess) { fprintf(stderr, "kernel_launch: memset failed\n"); return; }
    Ptrs p{};
    for (int i = 0; i < 24; ++i) p.in[i] = (const float*)d_in[i];
    p.out = (float*)d_out; p.ws = (unsigned char*)d_ws;
    hipLaunchKernelGGL(mk_fwd, dim3(256), dim3(512), LDS_BYTES, stream, p);
}
```

```cpp
#include <hip/hip_runtime.h>
#include <cstdio>
#include <cstdint>

#define LAS __attribute__((address_space(3)))
#define GAS __attribute__((address_space(1)))
typedef unsigned short bf16;
typedef short bf16x8 __attribute__((ext_vector_type(8)));
typedef short s16x4 __attribute__((ext_vector_type(4)));
typedef float f32x4 __attribute__((ext_vector_type(4)));
typedef float f32x2 __attribute__((ext_vector_type(2)));
typedef unsigned u32x4 __attribute__((ext_vector_type(4)));
typedef unsigned u32x2 __attribute__((ext_vector_type(2)));
typedef GAS unsigned gu32;

constexpr int NB = 16, SEQ = 4096, DM = 1024, CTXL = 256;
constexpr int T = NB * SEQ;
constexpr int TC = NB * CTXL;
constexpr int MALL = T + TC;
constexpr int INC = 3328;
constexpr int C_Q = 0, C_FF = 512, C_FB = 1024, C_I = 1536, C_G = 2048, C_AQ = 2560, C_AK = 3072, C_AV = 3200;
constexpr int NEXP = 64, NE1 = 65, FF = 256;
constexpr float ALPHA = 1.189207115002721f;
constexpr float LOG2E = 1.4426950408889634f;
constexpr float LOGF_MIN2 = -4.f * LOG2E;
constexpr float QSCALE = 0.125f * LOG2E;
constexpr int HALF_T = T / 2;
constexpr int HCAP = 311296;
constexpr int HTILES = HCAP / 256;

constexpr size_t MiB = 1u << 20;
constexpr size_t WS_CTL = 0, CTL_ZERO_BYTES = 1 * MiB;
constexpr size_t CTL_MOD = 65536;
constexpr size_t CTL_WGCNT = 524288;
constexpr size_t WS_SMALL = 1 * MiB;
constexpr size_t WS_WIN = 2 * MiB;
constexpr size_t WS_WOUT = 9 * MiB;
constexpr size_t WS_WR = 11 * MiB;
constexpr size_t WS_WGU = 12 * MiB;
constexpr size_t WS_WD = 77 * MiB;
constexpr size_t WS_H = 110 * MiB;
constexpr size_t WS_SEG = 110 * MiB;
constexpr size_t WS_SEGD = 183 * MiB;
constexpr size_t WS_OF = 184 * MiB;
constexpr size_t WS_Z = 250 * MiB;
constexpr size_t WS_Y = 692 * MiB;
constexpr size_t WS_R1 = 862 * MiB;
constexpr size_t WS_H2 = 110 * MiB;
constexpr size_t WS_RT = 238 * MiB;
constexpr size_t RT_TOKE = 0;
constexpr size_t RT_TOKW = 2 * MiB;
constexpr size_t RT_TOKP = 4 * MiB;
constexpr size_t RT_SLOTTOK = 6 * MiB;
constexpr size_t RT_SLOTW = 9 * MiB;
constexpr size_t WS_ACT = 254 * MiB;
constexpr size_t WS_SO = 558 * MiB;
constexpr size_t WS_MODP = 990 * MiB;
constexpr size_t WS_END = 997 * MiB;
constexpr float SO_SCALE = 32.f;

constexpr int CW_TMO = 0, CW_CODE = 1, CW_ERR = 2;
constexpr int CW_BAR = 4096;

constexpr int RING_BYTES = 131072;
constexpr int GIDX_OFF = RING_BYTES;
constexpr int GTAB_OFF = RING_BYTES + 2048;
constexpr int LDS_BYTES = 163840;
constexpr int MISC_TOP = LDS_BYTES - 512;
#ifdef PROBE_A
#define PSTAMP(lds, i) do { if (blockIdx.x == 0 && threadIdx.x == 0) ((volatile LAS unsigned long long*)((lds) + MISC_TOP + 64))[i] = __builtin_amdgcn_s_memrealtime(); } while (0)
#else
#define PSTAMP(lds, i) do {} while (0)
#endif

#define RLX_AGENT __ATOMIC_RELAXED, __HIP_MEMORY_SCOPE_AGENT
#define LDS_WAIT() asm volatile("s_waitcnt lgkmcnt(0)" ::: "memory")
#define VM_WAIT() asm volatile("s_waitcnt vmcnt(0)" ::: "memory")
#define WG_BAR() asm volatile("s_waitcnt lgkmcnt(0)\n\ts_barrier" ::: "memory")
__device__ __forceinline__ unsigned cvt_pk_bf16(float lo, float hi) { unsigned r; asm volatile("v_cvt_pk_bf16_f32 %0, %1, %2" : "=v"(r) : "v"(lo), "v"(hi)); return r; }
__device__ __forceinline__ float bf_lo(unsigned u) { return __uint_as_float(u << 16); }
__device__ __forceinline__ float bf_hi(unsigned u) { return __uint_as_float(u & 0xffff0000u); }
__device__ __forceinline__ float bf2f(bf16 h) { return __uint_as_float((unsigned)h << 16); }
__device__ __forceinline__ bf16 f2bf(float f) { return (bf16)(cvt_pk_bf16(f, 0.f) & 0xffffu); }
template <int CTRL> __device__ __forceinline__ float dpp_add(float x) { const int y = __builtin_amdgcn_update_dpp(0, __float_as_int(x), CTRL, 0xF, 0xF, false); return x + __int_as_float(y); }
__device__ __forceinline__ float wave_sum(float v) {
    v = dpp_add<0xB1>(v); v = dpp_add<0x4E>(v); v = dpp_add<0x141>(v); v = dpp_add<0x140>(v);
    const int b = __float_as_int(v);
    const float r0 = __int_as_float(__builtin_amdgcn_readlane(b, 0)), r1 = __int_as_float(__builtin_amdgcn_readlane(b, 16)), r2 = __int_as_float(__builtin_amdgcn_readlane(b, 32)), r3 = __int_as_float(__builtin_amdgcn_readlane(b, 48));
    return (r0 + r1) + (r2 + r3);
}
__device__ __forceinline__ float fast_exp2(float x) { return __builtin_amdgcn_exp2f(x); }
__device__ __forceinline__ float fast_exp(float x) { return __builtin_amdgcn_exp2f(x * LOG2E); }
__device__ __forceinline__ float fast_rcp(float x) { return __builtin_amdgcn_rcpf(x); }
__device__ __forceinline__ float silu_f(float v) { return v * fast_rcp(1.f + fast_exp(-v)); }
#define CAS __attribute__((address_space(4)))
__device__ __forceinline__ const float* IN(int i) { return ((const float* const CAS*)__builtin_amdgcn_kernarg_segment_ptr())[i]; }
__device__ __forceinline__ float* OUT() { return ((float* const CAS*)__builtin_amdgcn_kernarg_segment_ptr())[24]; }
__device__ __forceinline__ unsigned char* WS() { return ((unsigned char* const CAS*)__builtin_amdgcn_kernarg_segment_ptr())[25]; }
struct Ptrs { const float* in[24]; float* out; unsigned char* ws; };
namespace pg8 {
constexpr int BM = 256, BK = 64, HALF = 128, HTB = HALF * BK * 2, STAGE_BYTES = 8 * HTB, NXCD = 8, WGM = 8;
__host__ __device__ __forceinline__ int lds_byte(int r, int c) { const int st = (r >> 4) * 2 + (c >> 5), rr = r & 15, cc = c & 31, ob = rr * 64 + cc * 2; return st * 1024 + (ob ^ (((ob >> 9) & 1) << 5)); }
__host__ __device__ __forceinline__ void stage_rc(int b, int& R, int& C) { const int st = b / 1024, sb = b % 1024, swz = sb ^ (((sb >> 9) & 1) << 5); R = (st >> 1) * 16 + swz / 64; C = (st & 1) * 32 + (swz % 64) / 2; }
__host__ __device__ __forceinline__ int perm32(int rho) { const int n = rho >> 4, i = rho & 15; return 8 * (i >> 2) + 4 * n + (i & 3); }

struct Unit { const char* a; const char* b; const int* gidx; int pm, pn, aux; };

struct DenseOrder {
    const char* A; const char* Bt; int nM, nN, nwg, G, c, K;
    __device__ __forceinline__ void init(const void* A_, const void* Bt_, int M, int N, int K_, int G_, int c_) { A = (const char*)A_; Bt = (const char*)Bt_; nM = M / BM; nN = N / BM; nwg = nM * nN; G = G_; c = c_; K = K_; }
    __device__ __forceinline__ bool next(int i, Unit& u) const {
        const long L = (long)i * G + c; if (L >= nwg) return false;
        int wgid = (int)L; { const int q = nwg / NXCD, r = nwg % NXCD, xcd = wgid % NXCD, off = wgid / NXCD; wgid = (xcd < r ? xcd * (q + 1) : r * (q + 1) + (xcd - r) * q) + off; }
        const int nig = WGM * nN, gid = wgid / nig, fm = gid * WGM, gsz = (nM - fm) < WGM ? (nM - fm) : WGM;
        u.pm = fm + ((wgid % nig) % gsz); u.pn = (wgid % nig) / gsz; u.aux = 0; u.gidx = nullptr;
        u.a = A + (size_t)u.pm * BM * K * 2; u.b = Bt + (size_t)u.pn * BM * K * 2; return true;
    }
};

template <class Epi, class Sched, bool GATHER, bool ALIGN_EPI = true, bool PEEL = false>
__device__ __forceinline__ void gemm_phase(LAS unsigned char* lds, LAS unsigned char* gl, const int K, const Sched& S, const Epi& E) {
    int tid_ = threadIdx.x; asm volatile("" : "+v"(tid_));
    const int tid = tid_, wid = __builtin_amdgcn_readfirstlane(tid >> 6), lane = tid & 63, wr = wid >> 2, wc = wid & 3, fr = lane & 15, fq = lane >> 4;
    const int nt = K / BK;
    unsigned voffB[2], vC[2][2];
    const size_t hstep = (size_t)HALF * K * 2;
#pragma unroll
    for (int i = 0; i < 2; ++i) { int R, C; stage_rc(tid * 16 + i * 8192, R, C); const int Rb = (R & ~31) + perm32(R & 31);
        voffB[i] = (unsigned)(Rb * K + C) * 2u;
        vC[0][i] = (unsigned)(R * K + C) * 2u; vC[1][i] = vC[0][i] + (unsigned)hstep; }
    const size_t kstep = (size_t)(BK * 2);
    const unsigned ldsw = (unsigned)wid * 1024u;
    const int aoff = lds_byte(wr * 64 + fr, fq * 8), boff = lds_byte(wc * 32 + fr, fq * 8);
#define PG8_SA(b, h) (((b) * 2 + (h)) * HTB)
#define PG8_SB(b, h) ((4 + (b) * 2 + (h)) * HTB)
#define PG8_STAGE(bufoff, gbase, o0, o1) do { \
        __builtin_amdgcn_global_load_lds((const unsigned*)((const char*)(gbase) + (o0)), (LAS unsigned*)(lds + (bufoff) + ldsw), 16, 0, 0); \
        __builtin_amdgcn_global_load_lds((const unsigned*)((const char*)(gbase) + (o1)), (LAS unsigned*)(lds + (bufoff) + ldsw + 8192), 16, 0, 0); } while (0)
#define PG8_STAGEB(bufoff, gbase) PG8_STAGE(bufoff, gbase, voffB[0], voffB[1])
#define PG8_LDA(dst, b, h) do { _Pragma("unroll") for (int m = 0; m < 4; ++m) _Pragma("unroll") for (int k = 0; k < 2; ++k) dst[m][k] = *(const LAS bf16x8*)(lds + PG8_SA(b, h) + aoff + m * 2048 + k * 1024); } while (0)
#define PG8_LDB(dst, b, h) do { _Pragma("unroll") for (int n = 0; n < 2; ++n) _Pragma("unroll") for (int k = 0; k < 2; ++k) dst[n][k] = *(const LAS bf16x8*)(lds + PG8_SB(b, h) + boff + n * 2048 + k * 1024); } while (0)
#define PG8_MMA(ai, bj, At, Bt) do { __builtin_amdgcn_s_setprio(1); _Pragma("unroll") for (int m = 0; m < 4; ++m) _Pragma("unroll") for (int n = 0; n < 2; ++n) _Pragma("unroll") for (int k = 0; k < 2; ++k) \
        acc[ai][bj][m][n] = __builtin_amdgcn_mfma_f32_16x16x32_bf16(Bt[n][k], At[m][k], acc[ai][bj][m][n], 0, 0, 0); __builtin_amdgcn_s_setprio(0); } while (0)
#define PG8_MMA0(ai, bj, At, Bt) do { __builtin_amdgcn_s_setprio(1); _Pragma("unroll") for (int m = 0; m < 4; ++m) _Pragma("unroll") for (int n = 0; n < 2; ++n) { \
        acc[ai][bj][m][n] = __builtin_amdgcn_mfma_f32_16x16x32_bf16(Bt[n][0], At[m][0], (f32x4){0.f, 0.f, 0.f, 0.f}, 0, 0, 0); \
        acc[ai][bj][m][n] = __builtin_amdgcn_mfma_f32_16x16x32_bf16(Bt[n][1], At[m][1], acc[ai][bj][m][n], 0, 0, 0); } __builtin_amdgcn_s_setprio(0); } while (0)
#define PG8_WAIT_V(n) asm volatile("s_waitcnt vmcnt(" #n ")" ::: "memory")
#define PG8_WAIT_L(n) asm volatile("s_waitcnt lgkmcnt(" #n ")" ::: "memory")
#define PG8_BAR __builtin_amdgcn_s_barrier()
#define PG8_SCHED __builtin_amdgcn_sched_barrier(0)
    Unit cur, nxt; int ui = 0;
    if (!S.next(0, cur)) return;
    f32x4 acc[2][2][4][2];
    if constexpr (!PEEL) {
#pragma unroll
        for (int a = 0; a < 2; ++a)
#pragma unroll
            for (int b = 0; b < 2; ++b)
#pragma unroll
                for (int m = 0; m < 4; ++m)
#pragma unroll
                    for (int n = 0; n < 2; ++n) acc[a][b][m][n] = (f32x4){0.f, 0.f, 0.f, 0.f}; }
    bf16x8 At[4][2], B0[2][2], B1[2][2];
    const char* cA = cur.a; const char* cB = cur.b;
    if constexpr (GATHER) {
#pragma unroll
        for (int h = 0; h < 2; ++h)
#pragma unroll
            for (int i = 0; i < 2; ++i) { int R, C; stage_rc(tid * 16 + i * 8192, R, C); const int r = cur.gidx[h * HALF + R]; vC[h][i] = (unsigned)(r * K + C) * 2u; }
    }
    PG8_STAGEB(PG8_SB(0, 0), cB); PG8_STAGEB(PG8_SB(0, 1), cB + hstep); PG8_STAGE(PG8_SA(0, 0), cA, vC[0][0], vC[0][1]); PG8_STAGE(PG8_SA(0, 1), cA, vC[1][0], vC[1][1]);
    if (wr == 1) PG8_BAR;
    PG8_WAIT_V(2); PG8_BAR;
    PG8_STAGEB(PG8_SB(1, 0), cB + kstep); PG8_STAGE(PG8_SA(1, 0), cA + kstep, vC[0][0], vC[0][1]); PG8_STAGEB(PG8_SB(1, 1), cB + hstep + kstep);
    PG8_WAIT_V(6); PG8_BAR;
    for (;;) {
        const bool has_next = S.next(ui + 1, nxt);
        const char* nA = has_next ? nxt.a : cA; const char* nB = has_next ? nxt.b : cB;
        LAS unsigned char* gln = gl + ((ui + 1) & 1) * 1024;
        if constexpr (GATHER) { if (has_next && wid == 0) __builtin_amdgcn_global_load_lds((const unsigned*)(nxt.gidx + lane * 4), (LAS unsigned*)gln, 16, 0, 0); }
        if constexpr (PEEL) { const int t = 0;
            const bool last = false;
            const char* a1 = cA + (size_t)(t + 1) * kstep;
            const char* a2 = last ? nA : cA + (size_t)(t + 2) * kstep; const char* b2 = last ? nB : cB + (size_t)(t + 2) * kstep;
            const char* a3 = a2 + kstep; const char* b3 = b2 + kstep;
            asm volatile("" : "+s"(a1), "+s"(a2), "+s"(a3), "+s"(b2), "+s"(b3));
            unsigned w00 = vC[0][0], w01 = vC[0][1], w10 = vC[1][0], w11 = vC[1][1];
            unsigned ob0 = voffB[0], ob1 = voffB[1], obh0 = voffB[0] + (unsigned)hstep, obh1 = voffB[1] + (unsigned)hstep, oc10 = vC[1][0], oc11 = vC[1][1];
            asm volatile("" : "+v"(ob0), "+v"(ob1), "+v"(obh0), "+v"(obh1), "+v"(oc10), "+v"(oc11), "+v"(w00), "+v"(w01), "+v"(w10), "+v"(w11));
            if constexpr (GATHER) { if (last && has_next) {
#pragma unroll
                for (int i = 0; i < 2; ++i) { int R, C; stage_rc(tid * 16 + i * 8192, R, C); const int ra = ((const LAS int*)gln)[R], rb = ((const LAS int*)gln)[HALF + R];
                    const unsigned oa = (unsigned)(ra * K + C) * 2u, ob = (unsigned)(rb * K + C) * 2u; if (i == 0) { w00 = oa; w10 = ob; } else { w01 = oa; w11 = ob; } } } }
            PG8_LDB(B0, 0, 0); PG8_LDB(B1, 0, 1); PG8_SCHED; PG8_LDA(At, 0, 0); PG8_STAGE(PG8_SA(1, 1), a1, oc10, oc11);
            PG8_WAIT_V(8); PG8_WAIT_L(0); PG8_BAR; PG8_MMA0(0, 0, At, B0); PG8_MMA0(0, 1, At, B1); PG8_BAR; PG8_SCHED;
            PG8_LDA(At, 0, 1); PG8_STAGE(PG8_SB(0, 0), b2, ob0, ob1); PG8_STAGE(PG8_SB(0, 1), b2, obh0, obh1); PG8_STAGE(PG8_SA(0, 0), a2, w00, w01);
            PG8_WAIT_V(8); PG8_WAIT_L(0); PG8_BAR; PG8_MMA0(1, 0, At, B0); PG8_MMA0(1, 1, At, B1); PG8_BAR; PG8_SCHED;
            PG8_LDB(B0, 1, 0); PG8_LDB(B1, 1, 1); PG8_SCHED; PG8_LDA(At, 1, 0); PG8_STAGE(PG8_SA(0, 1), a2, w10, w11);
            PG8_WAIT_V(8); PG8_WAIT_L(0); PG8_BAR; PG8_MMA(0, 0, At, B0); PG8_MMA(0, 1, At, B1); PG8_BAR; PG8_SCHED;
            PG8_LDA(At, 1, 1); PG8_STAGE(PG8_SB(1, 0), b3, ob0, ob1); PG8_STAGE(PG8_SB(1, 1), b3, obh0, obh1); PG8_STAGE(PG8_SA(1, 0), a3, w00, w01);
            PG8_WAIT_V(8); PG8_WAIT_L(0); PG8_BAR; PG8_MMA(1, 0, At, B0); PG8_MMA(1, 1, At, B1); PG8_BAR; PG8_SCHED;
        }
#pragma unroll 1
        for (int t = PEEL ? 2 : 0; t < nt; t += 2) {
            const bool last = (t == nt - 2);
            const char* a1 = cA + (size_t)(t + 1) * kstep;
            const char* a2 = last ? nA : cA + (size_t)(t + 2) * kstep; const char* b2 = last ? nB : cB + (size_t)(t + 2) * kstep;
            const char* a3 = a2 + kstep; const char* b3 = b2 + kstep;
            asm volatile("" : "+s"(a1), "+s"(a2), "+s"(a3), "+s"(b2), "+s"(b3));
            unsigned w00 = vC[0][0], w01 = vC[0][1], w10 = vC[1][0], w11 = vC[1][1];
            unsigned ob0 = voffB[0], ob1 = voffB[1], obh0 = voffB[0] + (unsigned)hstep, obh1 = voffB[1] + (unsigned)hstep, oc10 = vC[1][0], oc11 = vC[1][1];
            asm volatile("" : "+v"(ob0), "+v"(ob1), "+v"(obh0), "+v"(obh1), "+v"(oc10), "+v"(oc11), "+v"(w00), "+v"(w01), "+v"(w10), "+v"(w11));
            if constexpr (GATHER) { if (last && has_next) {
#pragma unroll
                for (int i = 0; i < 2; ++i) { int R, C; stage_rc(tid * 16 + i * 8192, R, C); const int ra = ((const LAS int*)gln)[R], rb = ((const LAS int*)gln)[HALF + R];
                    const unsigned oa = (unsigned)(ra * K + C) * 2u, ob = (unsigned)(rb * K + C) * 2u; if (i == 0) { w00 = oa; w10 = ob; } else { w01 = oa; w11 = ob; } } } }
            PG8_LDB(B0, 0, 0); PG8_LDB(B1, 0, 1); PG8_SCHED; PG8_LDA(At, 0, 0); PG8_STAGE(PG8_SA(1, 1), a1, oc10, oc11);
            PG8_WAIT_V(8); PG8_WAIT_L(0); PG8_BAR; PG8_MMA(0, 0, At, B0); PG8_MMA(0, 1, At, B1); PG8_BAR; PG8_SCHED;
            PG8_LDA(At, 0, 1); PG8_STAGE(PG8_SB(0, 0), b2, ob0, ob1); PG8_STAGE(PG8_SB(0, 1), b2, obh0, obh1); PG8_STAGE(PG8_SA(0, 0), a2, w00, w01);
            PG8_WAIT_V(8); PG8_WAIT_L(0); PG8_BAR; PG8_MMA(1, 0, At, B0); PG8_MMA(1, 1, At, B1); PG8_BAR; PG8_SCHED;
            PG8_LDB(B0, 1, 0); PG8_LDB(B1, 1, 1); PG8_SCHED; PG8_LDA(At, 1, 0); PG8_STAGE(PG8_SA(0, 1), a2, w10, w11);
            PG8_WAIT_V(8); PG8_WAIT_L(0); PG8_BAR; PG8_MMA(0, 0, At, B0); PG8_MMA(0, 1, At, B1); PG8_BAR; PG8_SCHED;
            PG8_LDA(At, 1, 1); PG8_STAGE(PG8_SB(1, 0), b3, ob0, ob1); PG8_STAGE(PG8_SB(1, 1), b3, obh0, obh1); PG8_STAGE(PG8_SA(1, 0), a3, w00, w01);
            PG8_WAIT_V(8); PG8_WAIT_L(0); PG8_BAR; PG8_MMA(1, 0, At, B0); PG8_MMA(1, 1, At, B1); PG8_BAR; PG8_SCHED;
        }
        if constexpr (ALIGN_EPI) { if (wr == 0) PG8_BAR; }
        E(acc, cur, wr, wc, fr, fq);
#ifdef EXP_DOUBLE_EPI
        if (Epi::DOUBLE) { asm volatile("" ::: "memory"); E(acc, cur, wr, wc, fr, fq); }
#endif
        if (!has_next) break;
        if constexpr (!PEEL) {
#pragma unroll
            for (int a = 0; a < 2; ++a)
#pragma unroll
                for (int b = 0; b < 2; ++b)
#pragma unroll
                    for (int m = 0; m < 4; ++m)
#pragma unroll
                        for (int n = 0; n < 2; ++n) acc[a][b][m][n] = (f32x4){0.f, 0.f, 0.f, 0.f}; }
        cur = nxt; cA = nA; cB = nB; ++ui;
        if constexpr (GATHER) {
#pragma unroll
            for (int i = 0; i < 2; ++i) { int R, C; stage_rc(tid * 16 + i * 8192, R, C); const int ra = ((const LAS int*)gln)[R], rb = ((const LAS int*)gln)[HALF + R];
                vC[0][i] = (unsigned)(ra * K + C) * 2u; vC[1][i] = (unsigned)(rb * K + C) * 2u; } }
        if constexpr (ALIGN_EPI) { if (wr == 1) PG8_BAR; }
    }
    PG8_WAIT_V(0);
    if constexpr (!ALIGN_EPI) { if (wr == 0) PG8_BAR; }
    PG8_BAR;
#undef PG8_SA
#undef PG8_SB
#undef PG8_STAGE
#undef PG8_STAGEB
#undef PG8_LDA
#undef PG8_LDB
#undef PG8_MMA
#undef PG8_MMA0
#undef PG8_WAIT_V
#undef PG8_WAIT_L
#undef PG8_BAR
#undef PG8_SCHED
}
}
#define XB_TMO      128
#define XB_XCNT(j)  (256  + 64 * (j))
#define XB_XSUB(j)  (1280 + 64 * (j))
#define XB_XGEN(j)  (2304 + 64 * (j))
#define XB_TOP      3328
#define XB_TOPGEN   3392
#define XCD_BAR_WORDS 3456
#define XB_SPIN_CAP (1u << 18)

__device__ __forceinline__ unsigned xb_ld(unsigned* p)              { return __hip_atomic_load(p, __ATOMIC_RELAXED, __HIP_MEMORY_SCOPE_AGENT); }
__device__ __forceinline__ unsigned xb_add(unsigned* p, unsigned v) { return __hip_atomic_fetch_add(p, v, __ATOMIC_RELAXED, __HIP_MEMORY_SCOPE_AGENT); }
__device__ __forceinline__ unsigned xb_xcc_id() { return (unsigned)__builtin_amdgcn_s_getreg((3 << 11) | 20) & 0xFu; }
#define XB_SPIN(cond, bar) do { unsigned _sp = 0; while (cond) { __builtin_amdgcn_s_sleep(1); \
    if ((++_sp & 255u) == 0u) { if (xb_ld(&(bar)[XB_TMO])) break; if (_sp > XB_SPIN_CAP) { atomicAdd(&(bar)[XB_TMO], 1u); break; } } } } while (0)

struct XcdBarrier {
    unsigned* bar; unsigned x;
    volatile LAS unsigned* st;
};

__device__ __forceinline__ XcdBarrier xcd_barrier_post(unsigned* bar, volatile LAS unsigned* st) {
    XcdBarrier b; b.bar = bar; b.x = xb_xcc_id(); b.st = st;
    if (threadIdx.x == 0) (void)xb_add(&bar[XB_XCNT(b.x)], 1u);
    return b;
}
__device__ __forceinline__ void xcd_barrier_complete(unsigned* bar, unsigned x, unsigned& nloc, unsigned& nx) {
    const unsigned G = gridDim.x * gridDim.y * gridDim.z;
    unsigned sum, cnt, mine, sp = 0u;
    for (;;) {
        sum = 0u; cnt = 0u; mine = 0u;
#pragma unroll
        for (unsigned j = 0; j < 16; ++j) { const unsigned c = xb_ld(&bar[XB_XCNT(j)]); sum += c; cnt += (c > 0u) ? 1u : 0u; mine = (j == x) ? c : mine; }
        if (sum == G) break;
        __builtin_amdgcn_s_sleep(1);
        if ((++sp & 255u) == 0u) { if (xb_ld(&bar[XB_TMO])) break; if (sp > XB_SPIN_CAP) { atomicAdd(&bar[XB_TMO], 1u); break; } }
    }
    nloc = mine > 0u ? mine : 1u; nx = cnt > 0u ? cnt : 1u;
}

__device__ __forceinline__ void xcd_barrier(const XcdBarrier& b) {
    asm volatile("s_waitcnt vmcnt(0)" ::: "memory");
    __syncthreads();
    if (threadIdx.x == 0) {
        unsigned* bar = b.bar;
        __builtin_amdgcn_s_waitcnt(0);
        unsigned nloc = b.st[0], nx = b.st[1];
        if (nloc == 0u) { xcd_barrier_complete(bar, b.x, nloc, nx); b.st[0] = nloc; b.st[1] = nx; }
        const unsigned old = xb_add(&bar[XB_XSUB(b.x)], 1u);
        const unsigned gen = old / nloc;
        if (old + 1u == (gen + 1u) * nloc) {
            __builtin_amdgcn_fence(__ATOMIC_RELEASE, "agent");
            asm volatile("s_waitcnt vmcnt(0)" ::: "memory");
            const unsigned og = xb_add(&bar[XB_TOP], 1u);
            const unsigned tg = og / nx;
            if (og + 1u == (tg + 1u) * nx) xb_add(&bar[XB_TOPGEN], 1u);
            else XB_SPIN(xb_ld(&bar[XB_TOPGEN]) == tg, bar);
            __builtin_amdgcn_fence(__ATOMIC_ACQUIRE, "agent");
            xb_add(&bar[XB_XGEN(b.x)], 1u);
            asm volatile("s_waitcnt vmcnt(0)" ::: "memory");
        } else {
            XB_SPIN(xb_ld(&bar[XB_XGEN(b.x)]) == gen, bar);
            __builtin_amdgcn_fence(__ATOMIC_ACQUIRE, "agent");
            asm volatile("s_waitcnt vmcnt(0)" ::: "memory");
        }
    }
    __syncthreads();
}
__device__ __forceinline__ void p0_transpose_item(const float* W, int K, int N, bf16* WT, bf16* WTlo, int mode, LAS float* scr, int item, int lane) {
    const int nblk = N / 32, kb = item / nblk, nb = item % nblk, k0 = 64 * kb, n0 = 32 * nb;
#pragma unroll
    for (int i = 0; i < 8; ++i) { const int kk = 8 * i + (lane >> 3), c4 = 4 * (lane & 7); const f32x4 v = *(const GAS f32x4*)(W + (size_t)(k0 + kk) * N + n0 + c4);
        scr[kk * 33 + c4] = v.x; scr[kk * 33 + c4 + 1] = v.y; scr[kk * 33 + c4 + 2] = v.z; scr[kk * 33 + c4 + 3] = v.w; }
    LDS_WAIT(); asm volatile("" ::: "memory");
    const int rowbase = (mode == 0 || mode == 3) ? n0 : ((n0 >> 7) * 256 + (n0 & 127) + (mode == 2 ? 128 : 0));
    const float wsc = (mode == 3) ? SO_SCALE : 1.f;
    const int c = lane & 7;
#pragma unroll
    for (int j = 0; j < 4; ++j) { const int n = (lane >> 3) + 8 * j; const LAS float* s = scr + (8 * c) * 33 + n;
        float v[8];
#pragma unroll
        for (int q = 0; q < 8; ++q) v[q] = s[q * 33] * wsc;
        u32x4 o; o.x = cvt_pk_bf16(v[0], v[1]); o.y = cvt_pk_bf16(v[2], v[3]); o.z = cvt_pk_bf16(v[4], v[5]); o.w = cvt_pk_bf16(v[6], v[7]);
        *(GAS u32x4*)(WT + (size_t)(rowbase + n) * K + k0 + 8 * c) = o;
        if (WTlo) { u32x4 l; l.x = cvt_pk_bf16(v[0] - bf_lo(o.x), v[1] - bf_hi(o.x)); l.y = cvt_pk_bf16(v[2] - bf_lo(o.y), v[3] - bf_hi(o.y));
            l.z = cvt_pk_bf16(v[4] - bf_lo(o.z), v[5] - bf_hi(o.z)); l.w = cvt_pk_bf16(v[6] - bf_lo(o.w), v[7] - bf_hi(o.w));
            *(GAS u32x4*)(WTlo + (size_t)(rowbase + n) * K + k0 + 8 * c) = l; } }
    LDS_WAIT(); asm volatile("" ::: "memory");
}
__device__ __forceinline__ void p0_mod_task(const float* c, const float* c_ctx, const float* w_ada, const float* b_ada, float* mod, LAS float* scr, int task, int lane) {
    const int cg = task % 24, kc = task / 24, k0 = kc * 64, j0 = cg * 256 + lane * 4;
    for (int idx = lane; idx < 17 * 64; idx += 64) { const int r = idx >> 6, kk = idx & 63; const float v = (r < 16) ? c[r * DM + k0 + kk] : c_ctx[k0 + kk]; scr[idx] = v / (1.f + expf(-v)); }
    LDS_WAIT(); asm volatile("" ::: "memory");
    f32x4 acc[17];
#pragma unroll
    for (int r = 0; r < 17; ++r) acc[r] = (f32x4){0.f, 0.f, 0.f, 0.f};
#pragma unroll 4
    for (int kk = 0; kk < 64; ++kk) { const f32x4 w = *(const GAS f32x4*)(w_ada + (size_t)(k0 + kk) * 6144 + j0);
#pragma unroll
        for (int r = 0; r < 17; ++r) acc[r] += w * scr[r * 64 + kk]; }
    if (kc == 0) { const f32x4 b = *(const GAS f32x4*)(b_ada + j0);
#pragma unroll
        for (int r = 0; r < 17; ++r) acc[r] += b; }
#pragma unroll
    for (int r = 0; r < 17; ++r) *(GAS f32x4*)(mod + ((size_t)kc * 17 + r) * 6144 + j0) = acc[r];
    LDS_WAIT(); asm volatile("" ::: "memory");
}


__device__ __forceinline__ void p0a_mod(LAS unsigned char* lds, int vcu, int G, int wave, int lane) {
    LAS float* scr = (LAS float*)(lds + wave * 16384);
    unsigned char* ws = WS();
    const int gw0 = wave * G + vcu;
    if (gw0 < 384) p0_mod_task(IN(1), IN(3), IN(4), IN(5), (float*)(ws + WS_MODP), scr, gw0, lane);
    if (wave == 2 && (int)blockIdx.x == 200) {
        float* LB = (float*)(ws + WS_SMALL);
        for (int d = lane; d < 512; d += 64) { LB[d] = 1.f / (1.f + expf(IN(7)[512 + d] - IN(7)[d])); LB[512 + d] = 1.f / (1.f + expf(IN(8)[512 + d] - IN(8)[d])); }
    }
    if (wave == 2 && (int)blockIdx.x == 201) {
        f32x2* RT = (f32x2*)(ws + WS_SMALL + 4096);
        for (int e = lane; e < 1024; e += 64) { const int pos = e >> 4, i = e & 15; const double fr = pow(10000.0, -(double)i / 16.0), a = (double)pos * fr; RT[e] = (f32x2){(float)cos(a), (float)sin(a)}; }
    }
}
__device__ __forceinline__ void p0_prologue(LAS unsigned char* lds, int vcu, int G, int wave, int lane) {
    LAS float* scr = (LAS float*)(lds + wave * 16384);
    unsigned char* ws = WS();
    const int gw = vcu * 8 + wave, NGW = G * 8;
    constexpr int I_IN = 16 * 104, I_OUT = 16 * 32, I_E = 128, I_R = 32;
    constexpr int NITEMS = I_IN + I_OUT + NE1 * 3 * I_E + I_R;
    for (int it = gw; it < NITEMS; it += NGW) {
        int r = it;
        if (r < I_IN) { p0_transpose_item(IN(6), DM, INC, (bf16*)(ws + WS_WIN), nullptr, 0, scr, r, lane); continue; } r -= I_IN;
        if (r < I_OUT) { p0_transpose_item(IN(11), DM, DM, (bf16*)(ws + WS_WOUT), nullptr, 0, scr, r, lane); continue; } r -= I_OUT;
        if (r < NE1 * 3 * I_E) { const int e = r / (3 * I_E), q = r % (3 * I_E), typ = q / I_E, item = q % I_E;
            if (typ < 2) { const float* src = (e < NEXP) ? IN(16 + typ) + (size_t)e * DM * FF : IN(19 + typ);
                p0_transpose_item(src, DM, FF, (bf16*)(ws + WS_WGU) + (size_t)e * 512 * DM, nullptr, 1 + typ, scr, item, lane); }
            else { const float* src = (e < NEXP) ? IN(18) + (size_t)e * FF * DM : IN(21);
                p0_transpose_item(src, FF, DM, (bf16*)(ws + WS_WD) + (size_t)e * DM * FF, nullptr, 3, scr, item, lane); }
            continue; } r -= NE1 * 3 * I_E;
        p0_transpose_item(IN(14), DM, NEXP, (bf16*)(ws + WS_WR), (bf16*)(ws + WS_WR) + NEXP * DM, 0, scr, r, lane);
    }
}

__device__ __forceinline__ void p1_mod_reduce(int vcu, int wave, int lane) {
    if (wave == 7 && vcu < 136) { const float* modp = (const float*)(WS() + WS_MODP); float* mod = (float*)(WS() + WS_CTL + CTL_MOD);
        const int r = vcu >> 3, c0 = (vcu & 7) * 768;
#pragma unroll
        for (int i = 0; i < 3; ++i) { const int j = c0 + i * 256 + lane * 4; f32x4 a = (f32x4){0.f, 0.f, 0.f, 0.f};
#pragma unroll
            for (int kc = 0; kc < 16; ++kc) a += *(const GAS f32x4*)(modp + ((size_t)kc * 17 + r) * 6144 + j);
            *(GAS f32x4*)(mod + r * 6144 + j) = a; } }
}
__device__ __forceinline__ void p1_modulate(LAS unsigned char* lds, int vcu, int G, int wave, int lane) {
    const float* modp = (const float*)(WS() + WS_MODP); bf16* H = (bf16*)(WS() + WS_H);
    const int gw = vcu * 8 + wave, NGW = G * 8, per = (MALL + NGW - 1) / NGW;
    LAS float* MS = (LAS float*)lds;
    const int wr0 = vcu * 8 * per, wr1 = (wr0 + 8 * per - 1 < MALL - 1) ? wr0 + 8 * per - 1 : MALL - 1;
    const int bA = (wr0 < T) ? (wr0 >> 12) : 16, bB = (wr1 < T) ? (wr1 >> 12) : 16;
    { const int tid = threadIdx.x, which = tid >> 8, c8 = (tid & 255) * 8, bb = which ? bB : bA;
      f32x4 a0 = (f32x4){0.f, 0.f, 0.f, 0.f}, a1 = a0;
#pragma unroll 8
      for (int kc = 0; kc < 16; ++kc) { const float* pr = modp + ((size_t)kc * 17 + bb) * 6144 + c8; a0 += *(const GAS f32x4*)pr; a1 += *(const GAS f32x4*)(pr + 4); }
      *(LAS f32x4*)(MS + which * 2048 + c8) = a0; *(LAS f32x4*)(MS + which * 2048 + c8 + 4) = a1; }
    __syncthreads();
    int r0 = gw * per, r1 = r0 + per; if (r1 > MALL) r1 = MALL;
    int curb = -1; f32x4 sh[4], sc[4];
    for (int rb = r0; rb < r1; rb += 2) {
        const int b = (rb < T) ? (rb >> 12) : 16;
        if (b != curb) { curb = b; const LAS float* ms = MS + ((b == bA) ? 0 : 2048);
#pragma unroll
            for (int j = 0; j < 4; ++j) { sh[j] = *(const LAS f32x4*)(ms + 4 * lane + 256 * j); sc[j] = *(const LAS f32x4*)(ms + 1024 + 4 * lane + 256 * j) + 1.f; } }
        f32x4 v[2][4]; float s[2], s2[2], mean[2], rstd[2];
#pragma unroll
        for (int q = 0; q < 2; ++q) { const int r = rb + q; const float* src = (r < T) ? IN(0) + (size_t)r * DM : IN(2) + (size_t)(r - T) * DM; s[q] = 0.f;
#pragma unroll
            for (int j = 0; j < 4; ++j) { v[q][j] = *(const GAS f32x4*)(src + 4 * lane + 256 * j); s[q] += (v[q][j].x + v[q][j].y) + (v[q][j].z + v[q][j].w); } }
#pragma unroll
        for (int q = 0; q < 2; ++q) mean[q] = wave_sum(s[q]) * (1.f / DM);
#pragma unroll
        for (int q = 0; q < 2; ++q) { s2[q] = 0.f;
#pragma unroll
            for (int j = 0; j < 4; ++j) { v[q][j] = v[q][j] - mean[q]; s2[q] += (v[q][j].x * v[q][j].x + v[q][j].y * v[q][j].y) + (v[q][j].z * v[q][j].z + v[q][j].w * v[q][j].w); } }
#pragma unroll
        for (int q = 0; q < 2; ++q) rstd[q] = 1.f / sqrtf(wave_sum(s2[q]) * (1.f / DM) + 1e-6f);
#pragma unroll
        for (int q = 0; q < 2; ++q) { bf16* o = H + (size_t)(rb + q) * DM;
#pragma unroll
            for (int j = 0; j < 4; ++j) { const f32x4 y = v[q][j] * rstd[q] * sc[j] + sh[j]; u32x2 w; w.x = cvt_pk_bf16(y.x, y.y); w.y = cvt_pk_bf16(y.z, y.w); *(GAS u32x2*)(o + 4 * lane + 256 * j) = w; } }
    }
}

typedef f32x4 acc_t[2][2][4][2];
struct EpiZ {
#ifdef EXP_DOUBLE_EPI
    static constexpr bool DOUBLE = (EXP_DOUBLE_EPI == 1);
#endif
    bf16* Z; const float* LB; const f32x2* RT;
    __device__ __forceinline__ void operator()(const acc_t& acc, const pg8::Unit& u, int wr, int wc, int fr, int fq) const {
        const int row0 = u.pm * 256 + wr * 64 + fr, pn = u.pn, cb = wc * 32 + 8 * fq;
        const bool latent = u.pm < T / 256;
        float one_ = 1.f; asm volatile("" : "+v"(one_));
#pragma unroll
        for (int bj = 0; bj < 2; ++bj) {
            const int col = pn * 256 + bj * 128 + cb;
            const bool gate = (pn >= 2 && pn <= 5);
            const bool rope = latent && (pn == 10 || pn == 11 || (pn == 12 && bj == 0));
            const bool isq = (pn == 10 || pn == 11);
            f32x4 l0 = (f32x4){0.f, 0.f, 0.f, 0.f}, l1 = l0;
            if (gate) { const float* lb = LB + (col - C_FF); l0 = *(const GAS f32x4*)lb; l1 = *(const GAS f32x4*)(lb + 4); }
#pragma unroll
            for (int ai = 0; ai < 2; ++ai)
#pragma unroll
                for (int m = 0; m < 4; ++m) {
                    const int row = row0 + ai * 128 + m * 16;
                    f32x4 v0 = acc[ai][bj][m][0], v1 = acc[ai][bj][m][1];
                    if (gate) {
#pragma unroll
                        for (int j = 0; j < 4; ++j) { const float s0 = fast_rcp(1.f + fast_exp(-v0[j])), s1 = fast_rcp(1.f + fast_exp(-v1[j]));
                            v0[j] = __log2f(l0[j] + (1.f - l0[j]) * s0); v1[j] = __log2f(l1[j] + (1.f - l1[j]) * s1); }
                    } else if (rope) {
                        const int n = row & (SEQ - 1), pos = (wc & 1) ? (n & 63) : (n >> 6);
                        const f32x4* cs = (const f32x4*)(RT + pos * 16 + 8 * (fq & 1));
                        const f32x4 c0 = cs[0], c1 = cs[1], c2 = cs[2], c3 = cs[3];
                        const float sg = (fq & 2) ? 1.f : -1.f;
                        f32x4 o0, o1;
#pragma unroll
                        for (int j = 0; j < 4; ++j) { o0[j] = __shfl_xor(v0[j], 32); o1[j] = __shfl_xor(v1[j], 32); }
                        v0[0] = v0[0] * c0[0] + sg * o0[0] * c0[1]; v0[1] = v0[1] * c0[2] + sg * o0[1] * c0[3];
                        v0[2] = v0[2] * c1[0] + sg * o0[2] * c1[1]; v0[3] = v0[3] * c1[2] + sg * o0[3] * c1[3];
                        v1[0] = v1[0] * c2[0] + sg * o1[0] * c2[1]; v1[1] = v1[1] * c2[2] + sg * o1[1] * c2[3];
                        v1[2] = v1[2] * c3[0] + sg * o1[2] * c3[1]; v1[3] = v1[3] * c3[2] + sg * o1[3] * c3[3];
                    }
                    if (isq) { v0 = v0 * QSCALE; v1 = v1 * QSCALE; }
                    else if (!gate && !rope) { v0 = v0 * one_; v1 = v1 * one_; }
                    u32x4 w; w.x = cvt_pk_bf16(v0[0], v0[1]); w.y = cvt_pk_bf16(v0[2], v0[3]); w.z = cvt_pk_bf16(v1[0], v1[1]); w.w = cvt_pk_bf16(v1[2], v1[3]);
                    *(GAS u32x4*)((unsigned char*)Z + ((unsigned)row * (unsigned)INC + (unsigned)col) * 2u) = w;
                }
        }
    }
};
struct EpiR1 {
#ifdef EXP_DOUBLE_EPI
    static constexpr bool DOUBLE = (EXP_DOUBLE_EPI == 2);
#endif
    const float* x; const float* mod; bf16* R1;
    __device__ __forceinline__ void operator()(const acc_t& acc, const pg8::Unit& u, int wr, int wc, int fr, int fq) const {
        const int row0 = u.pm * 256 + wr * 64 + fr, b = (u.pm * 256) >> 12;
#pragma unroll
        for (int bj = 0; bj < 2; ++bj) {
            const int col = u.pn * 256 + bj * 128 + wc * 32 + 8 * fq;
            const f32x4 g0 = *(const GAS f32x4*)(mod + b * 6144 + 2048 + col), g1 = *(const GAS f32x4*)(mod + b * 6144 + 2048 + col + 4);
#pragma unroll
            for (int ai = 0; ai < 2; ++ai)
#pragma unroll
                for (int m = 0; m < 4; ++m) { const unsigned off = (unsigned)(row0 + ai * 128 + m * 16) * DM + (unsigned)col;
                    const f32x4 x0 = *(const GAS f32x4*)((const unsigned char*)x + off * 4u), x1 = *(const GAS f32x4*)((const unsigned char*)x + (off * 4u + 16u));
                    const f32x4 r0 = x0 * ALPHA + g0 * acc[ai][bj][m][0], r1 = x1 * ALPHA + g1 * acc[ai][bj][m][1];
                    u32x4 w; w.x = cvt_pk_bf16(r0[0], r0[1]); w.y = cvt_pk_bf16(r0[2], r0[3]); w.z = cvt_pk_bf16(r1[0], r1[1]); w.w = cvt_pk_bf16(r1[2], r1[3]);
                    *(GAS u32x4*)((unsigned char*)R1 + off * 2u) = w; }
        }
    }
};
__device__ __forceinline__ s16x4 ds_tr(const LAS unsigned char* p) { return __builtin_bit_cast(s16x4, __builtin_amdgcn_ds_read_tr16_b64_v4i16((LAS s16x4*)p)); }
#define MFMA16(a, b, c) __builtin_amdgcn_mfma_f32_16x16x32_bf16((a), (b), (c), 0, 0, 0)
constexpr int AP = 144;
__device__ __forceinline__ void attn_phase(LAS unsigned char* lds, int vcu, int G) {
    const bf16* Z = (const bf16*)(WS() + WS_Z); bf16* Y = (bf16*)(WS() + WS_Y); const float* sink = IN(10);
    int tid_ = threadIdx.x; asm volatile("" : "+v"(tid_)); const int tid = tid_, wid = __builtin_amdgcn_readfirstlane(tid >> 6), lane = tid & 63, fr = lane & 15, fq = lane >> 4;
    LAS unsigned char* KV = lds;
    const int lkey = tid >> 3, lch = tid & 7;
    for (int u = vcu; u < NB * 32 * 2; u += G) {
        const int b = u >> 6, band = (((u >> 1) & 31) + 8 * (u >> 8)) & 31, kvh = u & 1, qh = kvh * 4 + (wid >> 1), i0 = (wid & 1) * 64;
        const int twlo = (band == 0) ? 2 : 0, twhi = (band == 31) ? 3 : 5, ntile = 4 + (twhi - twlo + 1);
        LAS unsigned char* Qs = lds + 4 * 64 * AP + wid * (64 * AP);
#pragma unroll
        for (int i = 0; i < 8; ++i) { const int idx = lane + 64 * i, row = idx >> 3, ch = idx & 7;
            *(LAS u32x4*)(Qs + row * AP + ch * 16) = *(const GAS u32x4*)(Z + (size_t)(b * SEQ + band * 128 + i0 + row) * INC + C_AQ + qh * 64 + ch * 8); }
        float mrun[4]; f32x4 lacc[4], o[4][4];
        const float m0 = sink[qh] * LOG2E;
#pragma unroll
        for (int qt = 0; qt < 4; ++qt) { mrun[qt] = m0; lacc[qt] = (f32x4){1.f, 1.f, 1.f, 1.f};
#pragma unroll
            for (int dt = 0; dt < 4; ++dt) o[dt][qt] = (f32x4){0.f, 0.f, 0.f, 0.f}; }
        u32x4 kreg, vreg, kreg2, vreg2;
#define ATT_ROW(nn) (((nn) < 4) ? (size_t)(T + b * CTXL + (nn) * 64 + lkey) : (size_t)(b * SEQ + band * 128 - 128 + (twlo + (nn) - 4) * 64 + lkey))
        { const size_t row = ATT_ROW(0); kreg = *(const GAS u32x4*)(Z + row * INC + C_AK + kvh * 64 + lch * 8); vreg = *(const GAS u32x4*)(Z + row * INC + C_AV + kvh * 64 + lch * 8); }
        { const size_t row = ATT_ROW(1); kreg2 = *(const GAS u32x4*)(Z + row * INC + C_AK + kvh * 64 + lch * 8); vreg2 = *(const GAS u32x4*)(Z + row * INC + C_AV + kvh * 64 + lch * 8); }
        WG_BAR();
        *(LAS u32x4*)(KV + lkey * AP + lch * 16) = kreg; *(LAS u32x4*)(KV + 64 * AP + lkey * AP + lch * 16) = vreg;
        kreg = kreg2; vreg = vreg2;
        { const size_t row = ATT_ROW(2); kreg2 = *(const GAS u32x4*)(Z + row * INC + C_AK + kvh * 64 + lch * 8); vreg2 = *(const GAS u32x4*)(Z + row * INC + C_AV + kvh * 64 + lch * 8); }
        for (int n = 0; n < ntile; ++n) {
            WG_BAR();
            int z_ = 0; asm volatile("" : "+v"(z_));
            LAS unsigned char* Ks = KV + z_ + (n & 1) * (128 * AP); LAS unsigned char* Vs = Ks + 64 * AP;
            if (n + 1 < ntile) { LAS unsigned char* Kn = KV + ((n + 1) & 1) * (128 * AP);
                *(LAS u32x4*)(Kn + lkey * AP + lch * 16) = kreg; *(LAS u32x4*)(Kn + 64 * AP + lkey * AP + lch * 16) = vreg; kreg = kreg2; vreg = vreg2;
                if (n + 3 < ntile) { const size_t row = ATT_ROW(n + 3); kreg2 = *(const GAS u32x4*)(Z + row * INC + C_AK + kvh * 64 + lch * 8); vreg2 = *(const GAS u32x4*)(Z + row * INC + C_AV + kvh * 64 + lch * 8); } }
            const int tw = (n < 4) ? -1 : (twlo + n - 4);
            bool need = true, mask = false;
            if (tw >= 0) { need = (tw * 64 + 63 >= i0) && (tw * 64 <= i0 + 63 + 256); mask = !((tw * 64 >= i0 + 63) && (tw * 64 + 63 <= i0 + 256)); }
            if (!need) continue;
            bf16x8 kf[4][2];
#pragma unroll
            for (int kt = 0; kt < 4; ++kt)
#pragma unroll
                for (int ks = 0; ks < 2; ++ks) kf[kt][ks] = *(const LAS bf16x8*)(Ks + (kt * 16 + fr) * AP + ks * 64 + fq * 16);
#define ATT_S_ISSUE(q, dst) do { bf16x8 qf_[2]; \
                _Pragma("unroll") for (int ks = 0; ks < 2; ++ks) qf_[ks] = *(const LAS bf16x8*)(Qs + z_ + ((q) * 16 + fr) * AP + ks * 64 + fq * 16); \
                const float nm_ = -mrun[(q)];                         \
                _Pragma("unroll") for (int kt = 0; kt < 4; ++kt) { dst[kt] = MFMA16(kf[kt][0], qf_[0], ((f32x4){nm_, nm_, nm_, nm_})); dst[kt] = MFMA16(kf[kt][1], qf_[1], dst[kt]); } } while (0)
#define ATT_MAXV(sv, tmv) do { tmv = __builtin_fmaxf(__builtin_fmaxf(sv[0][0], sv[0][1]), sv[0][2]); \
                tmv = __builtin_fmaxf(__builtin_fmaxf(tmv, sv[0][3]), sv[1][0]); tmv = __builtin_fmaxf(__builtin_fmaxf(tmv, sv[1][1]), sv[1][2]); tmv = __builtin_fmaxf(__builtin_fmaxf(tmv, sv[1][3]), sv[2][0]); \
                tmv = __builtin_fmaxf(__builtin_fmaxf(tmv, sv[2][1]), sv[2][2]); tmv = __builtin_fmaxf(__builtin_fmaxf(tmv, sv[2][3]), sv[3][0]); tmv = __builtin_fmaxf(__builtin_fmaxf(tmv, sv[3][1]), sv[3][2]); tmv = __builtin_fmaxf(tmv, sv[3][3]); } while (0)
#define ATT_MAXX(tmv) do { auto r16 = __builtin_amdgcn_permlane16_swap(__float_as_uint(tmv), __float_as_uint(tmv), false, false); tmv = fmaxf(__uint_as_float(r16[0]), __uint_as_float(r16[1])); \
                  auto r32 = __builtin_amdgcn_permlane32_swap(__float_as_uint(tmv), __float_as_uint(tmv), false, false); tmv = fmaxf(__uint_as_float(r32[0]), __uint_as_float(r32[1])); } while (0)
#define ATT_MASK(sv, q) do { const int i = i0 + (q) * 16 + fr; \
                _Pragma("unroll") for (int kt = 0; kt < 4; ++kt) _Pragma("unroll") for (int r = 0; r < 4; ++r) { const int j = tw * 64 + kt * 16 + fq * 4 + r; if (!(j >= i && j <= i + 256)) sv[kt][r] = -INFINITY; } } while (0)
#define ATT_PACK(sv, pfv) do { _Pragma("unroll") for (int kt = 0; kt < 4; ++kt) _Pragma("unroll") for (int r = 0; r < 4; ++r) sv[kt][r] = fast_exp2(sv[kt][r]); \
                _Pragma("unroll") for (int k2 = 0; k2 < 2; ++k2) { u32x4 w; w.x = cvt_pk_bf16(sv[2 * k2][0], sv[2 * k2][1]); w.y = cvt_pk_bf16(sv[2 * k2][2], sv[2 * k2][3]); w.z = cvt_pk_bf16(sv[2 * k2 + 1][0], sv[2 * k2 + 1][1]); w.w = cvt_pk_bf16(sv[2 * k2 + 1][2], sv[2 * k2 + 1][3]); pfv[k2] = __builtin_bit_cast(bf16x8, w); } } while (0)
#pragma unroll
            for (int qp = 0; qp < 2; ++qp) {
                const int qa = 2 * qp, qb = 2 * qp + 1;
                f32x4 sa[4], sc4[4];
                ATT_S_ISSUE(qa, sa); ATT_S_ISSUE(qb, sc4);
                if (mask) { ATT_MASK(sa, qa); ATT_MASK(sc4, qb); }
                float tma, tmb; ATT_MAXV(sa, tma); ATT_MAXV(sc4, tmb);
                asm volatile("" : "+v"(tma), "+v"(tmb));
                ATT_MAXX(tma); ATT_MAXX(tmb);
                if (__any(tma > 0.f || tmb > 0.f)) {
                    const float dla = fmaxf(tma, 0.f), sca = fast_exp2(-dla), dlb = fmaxf(tmb, 0.f), scb = fast_exp2(-dlb); mrun[qa] += dla; mrun[qb] += dlb;
#pragma unroll
                    for (int kt = 0; kt < 4; ++kt) { sa[kt] = sa[kt] - dla; sc4[kt] = sc4[kt] - dlb; }
                    lacc[qa] = lacc[qa] * sca; lacc[qb] = lacc[qb] * scb;
#pragma unroll
                    for (int dt = 0; dt < 4; ++dt) { o[dt][qa] = o[dt][qa] * sca; o[dt][qb] = o[dt][qb] * scb; }
                }
                bf16x8 pfa[2], pfb[2];
                ATT_PACK(sa, pfa); ATT_PACK(sc4, pfb);
                { const bf16x8 ones = (bf16x8){0x3f80, 0x3f80, 0x3f80, 0x3f80, 0x3f80, 0x3f80, 0x3f80, 0x3f80};
                  lacc[qa] = MFMA16(ones, pfa[0], lacc[qa]); lacc[qb] = MFMA16(ones, pfb[0], lacc[qb]); lacc[qa] = MFMA16(ones, pfa[1], lacc[qa]); lacc[qb] = MFMA16(ones, pfb[1], lacc[qb]); }
#pragma unroll
                for (int dt = 0; dt < 4; ++dt) { bf16x8 vf[2];
#pragma unroll
                    for (int k2 = 0; k2 < 2; ++k2) { const LAS unsigned char* vp = Vs + (k2 * 32 + fq * 4 + (fr >> 2)) * AP + dt * 32 + (fr & 3) * 8;
                        const s16x4 lo = ds_tr(vp), hi = ds_tr(vp + 16 * AP); vf[k2] = (bf16x8){lo[0], lo[1], lo[2], lo[3], hi[0], hi[1], hi[2], hi[3]}; }
                    f32x4 a = o[dt][qa], c = o[dt][qb]; a = MFMA16(vf[0], pfa[0], a); c = MFMA16(vf[0], pfb[0], c); a = MFMA16(vf[1], pfa[1], a); c = MFMA16(vf[1], pfb[1], c); o[dt][qa] = a; o[dt][qb] = c; }
            }
        }
#undef ATT_MAXV
#undef ATT_MAXX
#undef ATT_MASK
#undef ATT_PACK
        asm volatile("" : "+v"(o[3][3]), "+v"(lacc[3]));
#pragma unroll
        for (int qt = 0; qt < 4; ++qt) { const float rl = 1.f / lacc[qt][0];
            bf16* yp = Y + (size_t)(b * SEQ + band * 128 + i0 + qt * 16 + fr) * DM + 512 + qh * 64;
#pragma unroll
            for (int dp = 0; dp < 2; ++dp) {
                const f32x4 a = o[2 * dp][qt] * rl, c = o[2 * dp + 1][qt] * rl;
                const unsigned a0 = cvt_pk_bf16(a[0], a[1]), a1 = cvt_pk_bf16(a[2], a[3]), c0 = cvt_pk_bf16(c[0], c[1]), c1 = cvt_pk_bf16(c[2], c[3]);
                const auto s0 = __builtin_amdgcn_permlane16_swap(a0, c0, false, false), s1 = __builtin_amdgcn_permlane16_swap(a1, c1, false, false);
                const u32x4 w = (u32x4){s0[0], s1[0], s0[1], s1[1]};
                *(GAS u32x4*)(yp + (2 * dp + (fq & 1)) * 16 + 4 * (fq & 2)) = w; } }
    }
#undef ATT_ROW
#undef ATT_S_ISSUE
    __syncthreads();
}
constexpr int HP = 272;
constexpr int L_KB = 0;
constexpr int L_KD = 64 * HP;
constexpr int L_QH = 128 * HP;
constexpr int L_QV = 192 * HP;
constexpr int L_V = 240 * HP;
constexpr int L_ST = L_V + 64 * HP;
constexpr int L_ATT = L_ST + 128 * HP;
constexpr int L_TOT = L_ATT + 8 * 16 * 144;
constexpr int L_FQ = L_TOT + 2048;
constexpr int L_FE = L_FQ + 2048;
constexpr int L_DEC = L_FE + 2048;
constexpr int L_SS = L_DEC + 512;
constexpr int L_KH0 = L_KB;
static_assert(L_SS + 512 <= MISC_TOP, "HGRN LDS map");

struct HgrnChain { const bf16* Z; int rowbase; int h; int dir; };

template <bool WITH_OUT>
struct HgrnStep {
    unsigned greg[16], qreg[16]; u32x4 vreg[2];
    __device__ __forceinline__ void prefetch(const HgrnChain& c, int c0, int wid, int lane, int tid) {
        const int n = wid & 3, role = wid >> 2;
        const int gcol = (c.dir ? C_FB : C_FF) + c.h * 128 + 2 * lane, qcol = C_Q + c.h * 128 + 2 * lane;
#pragma unroll
        for (int t = 0; t < 16; ++t) { const int p = 16 * n + t, tk = c.dir ? (c0 + 63 - p) : (c0 + p); const bf16* rp = c.Z + (size_t)(c.rowbase + tk) * INC;
            greg[t] = *(const GAS unsigned*)(rp + gcol); if (WITH_OUT && role == 1) qreg[t] = *(const GAS unsigned*)(rp + qcol); }
#pragma unroll
        for (int i = 0; i < 2; ++i) { const int idx = tid + 512 * i, p = idx >> 4, ch = idx & 15, tk = c.dir ? (c0 + 63 - p) : (c0 + p);
            vreg[i] = *(const GAS u32x4*)(c.Z + (size_t)(c.rowbase + tk) * INC + C_I + c.h * 128 + ch * 8); }
    }
};

struct HgrnEpf { u32x4 of[2], zg[2]; const bf16* ofp; const bf16* zgp; bool on;
    __device__ __forceinline__ void issue() { if (on) { of[0] = *(const GAS u32x4*)ofp; of[1] = *(const GAS u32x4*)(ofp + 8); zg[0] = *(const GAS u32x4*)zgp; zg[1] = *(const GAS u32x4*)(zgp + 8); } } };
template <bool WITH_OUT>
__device__ __forceinline__ void hgrn_chunk(LAS unsigned char* lds, HgrnStep<WITH_OUT>& pf, f32x4 (&st)[8], f32x4 (&oacc)[4], float (&segsum)[2],
                                           const HgrnChain& c, int next_c0, bool has_next, HgrnEpf& epf, int wid, int lane, int tid) {
    const int n = wid & 3, role = wid >> 2, fr = lane & 15, fq = lane >> 4, d0 = 2 * lane;
    LAS float* TOT = (LAS float*)(lds + L_TOT); LAS float* FQ = (LAS float*)(lds + L_FQ); LAS float* DEC = (LAS float*)(lds + L_DEC);
    float one_ = 1.f; asm volatile("" : "+v"(one_));


    f32x2 gl[16], cs[16];
    { f32x2 a = (f32x2){0.f, 0.f};
#pragma unroll
      for (int t = 0; t < 16; ++t) { gl[t] = (f32x2){bf_lo(pf.greg[t]), bf_hi(pf.greg[t])}; a += (f32x2){fmaxf(gl[t].x, LOGF_MIN2), fmaxf(gl[t].y, LOGF_MIN2)}; cs[t] = a; } }
    if (role == 0) *(LAS f32x2*)(TOT + n * 128 + d0) = cs[15];
#pragma unroll
    for (int i = 0; i < 2; ++i) { const int idx = tid + 512 * i, p = idx >> 4, ch = idx & 15; *(LAS u32x4*)(lds + L_V + p * HP + ch * 16) = pf.vreg[i]; }
    WG_BAR();
    { int z_ = 0; asm volatile("" : "+v"(z_)); lds = lds + z_; }
    f32x2 R[5];
    { R[0] = (f32x2){0.f, 0.f};
#pragma unroll
      for (int q = 0; q < 4; ++q) R[q + 1] = R[q] + *(const LAS f32x2*)(TOT + q * 128 + d0); }
#define EXP2V(v) ((f32x2){fast_exp2((v).x), fast_exp2((v).y)})
    if (role == 0) {
        const f32x2 tot = cs[15];
        const f32x2 eD = EXP2V(-tot);
        f32x2 E = (f32x2){1.f, 1.f};
#pragma unroll
        for (int t = 15; t >= 0; --t) {
            if ((t & 3) == 3) __builtin_amdgcn_sched_barrier(0);
            const f32x2 f = EXP2V(gl[t]);
            const f32x2 ke = (1.f - f) * E;
            E = E * (f32x2){fmaxf(f.x, 0.01831563888873418f), fmaxf(f.y, 0.01831563888873418f)};
            const int rowoff = (16 * n + t) * HP + d0 * 2;
            *(LAS unsigned*)(lds + L_KB + rowoff) = cvt_pk_bf16(ke.x, ke.y);
            { const f32x2 v = ke * eD; *(LAS unsigned*)(lds + L_KD + rowoff) = cvt_pk_bf16(v.x, v.y); }
        }
        *(LAS f32x2*)(FQ + n * 128 + d0) = EXP2V(R[n]);
        *(LAS f32x2*)((LAS float*)(lds + L_FE) + n * 128 + d0) = EXP2V(R[4] - R[n + 1]);
        if (n == 3) { *(LAS f32x2*)(DEC + d0) = EXP2V(R[4]); segsum[0] += R[4].x; segsum[1] += R[4].y; }
    } else {
        const f32x2 f20 = EXP2V(R[n] - R[1]), f31 = EXP2V(R[3] - R[2]);
#pragma unroll
        for (int t = 0; t < 16; ++t) { if ((t & 3) == 0) __builtin_amdgcn_sched_barrier(0);
            const f32x2 v = (f32x2){bf_lo(pf.qreg[t]), bf_hi(pf.qreg[t])} * EXP2V(cs[t]);
            *(LAS unsigned*)(lds + L_QH + (16 * n + t) * HP + d0 * 2) = cvt_pk_bf16(v.x, v.y);
            if (n >= 2) { const f32x2 w = v * f20; *(LAS unsigned*)(lds + L_QV + ((n - 2) * 16 + t) * HP + d0 * 2) = cvt_pk_bf16(w.x, w.y); }
            if (n == 3) { const f32x2 w = v * f31; *(LAS unsigned*)(lds + L_QV + (32 + t) * HP + d0 * 2) = cvt_pk_bf16(w.x, w.y); } }
    }
    WG_BAR();
    { int z_ = 0; asm volatile("" : "+v"(z_)); lds = lds + z_; }
    epf.issue();
    if (WITH_OUT) {
        const int eh = wid >> 2;
        bf16x8 aq[4];
#pragma unroll
        for (int ks = 0; ks < 4; ++ks) aq[ks] = *(const LAS bf16x8*)(lds + L_QH + (16 * n + fr) * HP + ks * 64 + fq * 16);
        unsigned pw[4][2];
#pragma unroll
        for (int m = 0; m < 4; ++m) {
            if (m <= n) { f32x4 a = (f32x4){0.f, 0.f, 0.f, 0.f};
                const int kb = ((m == n) ? L_KD : L_KB) + (16 * m + fr) * HP + fq * 16;
                const int qv = L_QV + (((n == 2) ? 0 : (16 + 16 * m)) + fr) * HP + fq * 16;
                if (m + 2 <= n) {
#pragma unroll
                    for (int ks = 0; ks < 4; ++ks) { const bf16x8 bk = *(const LAS bf16x8*)(lds + kb + ks * 64), av = *(const LAS bf16x8*)(lds + qv + ks * 64); a = MFMA16(bk, av, a); }
                } else {
#pragma unroll
                    for (int ks = 0; ks < 4; ++ks) { const bf16x8 bk = *(const LAS bf16x8*)(lds + kb + ks * 64); a = MFMA16(bk, aq[ks], a); }
                }
                float v[4];
#pragma unroll
                for (int r = 0; r < 4; ++r) { v[r] = a[r] * one_; if (m == n && fq * 4 + r > fr) v[r] = 0.f; }
                pw[m][0] = cvt_pk_bf16(v[0], v[1]); pw[m][1] = cvt_pk_bf16(v[2], v[3]); }
            else { pw[m][0] = 0u; pw[m][1] = 0u; }
        }
        bf16x8 qt[4];
#pragma unroll
        for (int ks = 0; ks < 4; ++ks) { const f32x4 f0 = *(const LAS f32x4*)(FQ + n * 128 + ks * 32 + fq * 8), f1 = *(const LAS f32x4*)(FQ + n * 128 + ks * 32 + fq * 8 + 4);
            const u32x4 w = __builtin_bit_cast(u32x4, aq[ks]); u32x4 o;
            { const f32x2 a = (f32x2){bf_lo(w.x), bf_hi(w.x)} * (f32x2){f0[0], f0[1]}, b = (f32x2){bf_lo(w.y), bf_hi(w.y)} * (f32x2){f0[2], f0[3]}; o.x = cvt_pk_bf16(a.x, a.y); o.y = cvt_pk_bf16(b.x, b.y); }
            { const f32x2 a = (f32x2){bf_lo(w.z), bf_hi(w.z)} * (f32x2){f1[0], f1[1]}, b = (f32x2){bf_lo(w.w), bf_hi(w.w)} * (f32x2){f1[2], f1[3]}; o.z = cvt_pk_bf16(a.x, a.y); o.w = cvt_pk_bf16(b.x, b.y); }
            qt[ks] = __builtin_bit_cast(bf16x8, o); }
        bf16x8 pa[2];
        pa[0] = __builtin_bit_cast(bf16x8, ((u32x4){pw[0][0], pw[0][1], pw[1][0], pw[1][1]})); pa[1] = __builtin_bit_cast(bf16x8, ((u32x4){pw[2][0], pw[2][1], pw[3][0], pw[3][1]}));
#pragma unroll
        for (int et = 0; et < 4; ++et) { const int eb = 4 * eh + et; f32x4 a = (f32x4){0.f, 0.f, 0.f, 0.f};
            bf16x8 bs[4], bv[2];
#pragma unroll
            for (int ks = 0; ks < 4; ++ks) bs[ks] = *(const LAS bf16x8*)(lds + L_ST + (eb * 16 + fr) * HP + ks * 64 + fq * 16);
#pragma unroll
            for (int k2 = 0; k2 < 2; ++k2) { const LAS unsigned char* vp = lds + L_V + (32 * k2 + 4 * fq + (fr >> 2)) * HP + eb * 32 + (fr & 3) * 8;
                const s16x4 lo = ds_tr(vp), hi = ds_tr(vp + 16 * HP); bv[k2] = (bf16x8){lo[0], lo[1], lo[2], lo[3], hi[0], hi[1], hi[2], hi[3]}; }
#pragma unroll
            for (int ks = 0; ks < 4; ++ks) a = MFMA16(qt[ks], bs[ks], a);
            a = MFMA16(pa[0], bv[0], a);
            if (n >= 2) a = MFMA16(pa[1], bv[1], a);
            oacc[et] = a; }
    }
    { int z_ = 0; asm volatile("" : "+v"(z_)); lds = lds + z_; }
    {
        const f32x4 dec = *(const LAS f32x4*)(DEC + 16 * wid + 4 * fq);
        bf16x8 ak[2];
#pragma unroll
        for (int k2 = 0; k2 < 2; ++k2) { const LAS unsigned char* kp = lds + L_KB + (32 * k2 + 8 * fq + (fr >> 2)) * HP + wid * 32 + (fr & 3) * 8;
            const s16x4 lo = ds_tr(kp), hi = ds_tr(kp + 4 * HP);
            const float fe = ((const LAS float*)(lds + L_FE))[(2 * k2 + (fq >> 1)) * 128 + 16 * wid + fr];
            const u32x2 l2 = __builtin_bit_cast(u32x2, lo), h2 = __builtin_bit_cast(u32x2, hi); u32x4 o;
            o.x = cvt_pk_bf16(bf_lo(l2.x) * fe, bf_hi(l2.x) * fe); o.y = cvt_pk_bf16(bf_lo(l2.y) * fe, bf_hi(l2.y) * fe);
            o.z = cvt_pk_bf16(bf_lo(h2.x) * fe, bf_hi(h2.x) * fe); o.w = cvt_pk_bf16(bf_lo(h2.y) * fe, bf_hi(h2.y) * fe);
            ak[k2] = __builtin_bit_cast(bf16x8, o); }
#pragma unroll
        for (int eb = 0; eb < 8; ++eb) { f32x4 a = st[eb] * dec;
#pragma unroll
            for (int k2 = 0; k2 < 2; ++k2) { const LAS unsigned char* vp = lds + L_V + (32 * k2 + 8 * fq + (fr >> 2)) * HP + eb * 32 + (fr & 3) * 8;
                const s16x4 lo = ds_tr(vp), hi = ds_tr(vp + 4 * HP); const bf16x8 bv = (bf16x8){lo[0], lo[1], lo[2], lo[3], hi[0], hi[1], hi[2], hi[3]}; a = MFMA16(ak[k2], bv, a); }
            st[eb] = a; }
    }
    if (has_next) pf.prefetch(c, next_c0, wid, lane, tid);
    WG_BAR();
    if (WITH_OUT) {
#pragma unroll
        for (int eb = 0; eb < 8; ++eb) { const f32x4 t = st[eb] * one_; u32x2 w; w.x = cvt_pk_bf16(t[0], t[1]); w.y = cvt_pk_bf16(t[2], t[3]); *(LAS u32x2*)(lds + L_ST + (eb * 16 + fr) * HP + (16 * wid + 4 * fq) * 2) = w; }
    }
}

__device__ __forceinline__ void hgrn_state_init(f32x4 (&st)[8], const float* SEG, const float* SEGD, int chain, int slot_first, int slot_step, int nslots_latent, int wid, int lane) {
    const int fr = lane & 15, fq = lane >> 4;
#pragma unroll
    for (int eb = 0; eb < 8; ++eb) st[eb] = (f32x4){0.f, 0.f, 0.f, 0.f};
    f32x4 Pd = (f32x4){1.f, 1.f, 1.f, 1.f};
    int slot = slot_first;
    for (int it = 0; it <= nslots_latent; ++it) {
        const int sl = (it < nslots_latent) ? slot : 0;
        const float* X = SEG + ((size_t)chain * 9 + sl) * 16384 + (size_t)(wid * 64 + lane) * 32;
#pragma unroll
        for (int eb = 0; eb < 8; ++eb) st[eb] += Pd * *(const GAS f32x4*)(X + 4 * eb);
        const f32x4 dd = *(const GAS f32x4*)(SEGD + ((size_t)chain * 9 + sl) * 128 + 16 * wid + 4 * fq);
        Pd = Pd * dd;
        const bool live = (Pd[0] != 0.f) || (Pd[1] != 0.f) || (Pd[2] != 0.f) || (Pd[3] != 0.f);
        if (!__any(live)) break;
        slot += slot_step;
    }
}

constexpr int PA_KF = 0, PA_KB = 128 * HP, PA_V = 256 * HP, PA_TF = 384 * HP, PA_TB = PA_TF + 4096, PA_DEC = PA_TB + 4096;
struct PaRows { unsigned gf[16], gb[16]; };
__device__ __forceinline__ void pa_unit(int u, int& b, int& h, int& slot, int& nst, int& tok0, int& rowbase) {
    if (u < 512) { b = u >> 5; h = (u >> 3) & 3; slot = 1 + (u & 7); nst = 4; tok0 = (u & 7) * 512; rowbase = b * SEQ; }
    else { const int v = u - 512; b = v >> 2; h = v & 3; slot = 0; nst = 2; tok0 = 0; rowbase = T + b * CTXL; }
}
__device__ __forceinline__ void pa_load(PaRows& r, const bf16* Z, int rowbase, int h, int c0, int wid, int lane) {
    const unsigned char* base = (const unsigned char*)(Z + (size_t)(rowbase + c0) * INC + h * 128);
    unsigned go = (unsigned)(16 * wid * INC + 2 * lane) * 2u;
    asm volatile("" : "+v"(go));
#pragma unroll
    for (int t = 0; t < 16; ++t) { r.gf[t] = *(const GAS unsigned*)(base + (go + (unsigned)(t * INC + C_FF) * 2u)); r.gb[t] = *(const GAS unsigned*)(base + (go + (unsigned)(t * INC + C_FB) * 2u)); }
}
__device__ __forceinline__ void pa_load_v(u32x4 (&vr)[4], const bf16* Z, int rowbase, int h, int c0, int tid) {
    const unsigned char* base = (const unsigned char*)(Z + (size_t)(rowbase + c0) * INC + h * 128);
    unsigned vo = (unsigned)((tid >> 4) * INC + (tid & 15) * 8 + C_I) * 2u;
    asm volatile("" : "+v"(vo));
#pragma unroll
    for (int i = 0; i < 4; ++i) vr[i] = *(const GAS u32x4*)(base + (vo + (unsigned)(32 * i * INC) * 2u));
}
__device__ __forceinline__ void pa_step(LAS unsigned char* lds, const PaRows& r, u32x4 (&vr)[4], f32x4 (&stf)[8], f32x4 (&stb)[8], f32x2& segf, f32x2& lowb, int wid, int lane, int tid,
                                        const bf16* Z, bool nv, int nrowbase, int nh, int nc0) {
    const int fr = lane & 15, fq = lane >> 4, d0 = 2 * lane;
    LAS float* TF = (LAS float*)(lds + PA_TF); LAS float* TB = (LAS float*)(lds + PA_TB); LAS float* DEC = (LAS float*)(lds + PA_DEC);
    f32x2 totf = (f32x2){0.f, 0.f}, totb = totf;
#pragma unroll
    for (int t = 0; t < 16; ++t) { totf += (f32x2){fmaxf(bf_lo(r.gf[t]), LOGF_MIN2), fmaxf(bf_hi(r.gf[t]), LOGF_MIN2)}; totb += (f32x2){fmaxf(bf_lo(r.gb[t]), LOGF_MIN2), fmaxf(bf_hi(r.gb[t]), LOGF_MIN2)}; }
    *(LAS f32x2*)(TF + wid * 128 + d0) = totf; *(LAS f32x2*)(TB + wid * 128 + d0) = totb;
#pragma unroll
    for (int i = 0; i < 4; ++i) { const int idx = tid + 512 * i, p = idx >> 4, ch = idx & 15; *(LAS u32x4*)(lds + PA_V + p * HP + ch * 16) = vr[i]; }
    if (nv) pa_load_v(vr, Z, nrowbase, nh, nc0, tid);
    WG_BAR();
    { int z_ = 0; asm volatile("" : "+v"(z_)); lds = lds + z_; }
    f32x2 allf = (f32x2){0.f, 0.f}, aftf = allf, allb = allf, befb = allf;
#pragma unroll
    for (int q = 0; q < 8; ++q) { const f32x2 a = *(const LAS f32x2*)(TF + q * 128 + d0), c = *(const LAS f32x2*)(TB + q * 128 + d0); allf += a; allb += c; if (q > wid) aftf += a; if (q < wid) befb += c; }
    const float FMIN = 0.01831563888873418f;
    { f32x2 E = EXP2V(aftf);
#pragma unroll
      for (int t = 15; t >= 0; --t) { unsigned w = r.gf[t]; asm volatile("" : "+v"(w)); const f32x2 f = EXP2V(((f32x2){bf_lo(w), bf_hi(w)}));
          const f32x2 v = (1.f - f) * E; *(LAS unsigned*)(lds + PA_KF + (16 * wid + t) * HP + d0 * 2) = cvt_pk_bf16(v.x, v.y);
          E = E * (f32x2){fmaxf(f.x, FMIN), fmaxf(f.y, FMIN)}; } }
    { f32x2 E = EXP2V(lowb + befb);
#pragma unroll
      for (int t = 0; t < 16; ++t) { unsigned w = r.gb[t]; asm volatile("" : "+v"(w)); const f32x2 f = EXP2V(((f32x2){bf_lo(w), bf_hi(w)}));
          const f32x2 v = (1.f - f) * E; *(LAS unsigned*)(lds + PA_KB + (16 * wid + t) * HP + d0 * 2) = cvt_pk_bf16(v.x, v.y);
          E = E * (f32x2){fmaxf(f.x, FMIN), fmaxf(f.y, FMIN)}; } }
    if (wid == 7) *(LAS f32x2*)(DEC + d0) = EXP2V(allf);
    segf += allf; lowb += allb;
    WG_BAR();
    { int z_ = 0; asm volatile("" : "+v"(z_)); lds = lds + z_; }
    { const f32x4 dec = *(const LAS f32x4*)(DEC + 16 * wid + 4 * fq);
      bf16x8 akf[4], akb[4];
#pragma unroll
      for (int k2 = 0; k2 < 4; ++k2) { const int off = (32 * k2 + 8 * fq + (fr >> 2)) * HP + wid * 32 + (fr & 3) * 8;
          { const s16x4 lo = ds_tr(lds + PA_KF + off), hi = ds_tr(lds + PA_KF + off + 4 * HP); akf[k2] = (bf16x8){lo[0], lo[1], lo[2], lo[3], hi[0], hi[1], hi[2], hi[3]}; }
          { const s16x4 lo = ds_tr(lds + PA_KB + off), hi = ds_tr(lds + PA_KB + off + 4 * HP); akb[k2] = (bf16x8){lo[0], lo[1], lo[2], lo[3], hi[0], hi[1], hi[2], hi[3]}; } }
#pragma unroll
      for (int eb = 0; eb < 8; ++eb) { f32x4 a = stf[eb] * dec, c = stb[eb];
#pragma unroll
          for (int k2 = 0; k2 < 4; ++k2) { const LAS unsigned char* vp = lds + PA_V + (32 * k2 + 8 * fq + (fr >> 2)) * HP + eb * 32 + (fr & 3) * 8;
              const s16x4 lo = ds_tr(vp), hi = ds_tr(vp + 4 * HP); const bf16x8 bv = (bf16x8){lo[0], lo[1], lo[2], lo[3], hi[0], hi[1], hi[2], hi[3]}; a = MFMA16(akf[k2], bv, a); c = MFMA16(akb[k2], bv, c); }
          stf[eb] = a; stb[eb] = c; } }
    WG_BAR();
}
__device__ __forceinline__ void hgrn_pass_a(LAS unsigned char* lds, int vcu, int G) {
    const bf16* Z = (const bf16*)(WS() + WS_Z); float* SEG = (float*)(WS() + WS_SEG); float* SEGD = (float*)(WS() + WS_SEGD);
    int tid_ = threadIdx.x; asm volatile("" : "+v"(tid_)); const int tid = tid_, wid = __builtin_amdgcn_readfirstlane(tid >> 6), lane = tid & 63, d0 = 2 * lane;
    PaRows ra, rb; u32x4 vr[4];
    if (vcu < 576) { int b, h, slot, nst, tok0, rowbase; pa_unit(vcu, b, h, slot, nst, tok0, rowbase); pa_load(ra, Z, rowbase, h, tok0, wid, lane); pa_load_v(vr, Z, rowbase, h, tok0, tid); }
    for (int u = vcu; u < 576; u += G) {
        int b, h, slot, nst, tok0, rowbase; pa_unit(u, b, h, slot, nst, tok0, rowbase);
        int b2 = 0, h2 = 0, slot2, nst2, tok2 = 0, rowbase2 = 0; const bool more = u + G < 576; if (more) pa_unit(u + G, b2, h2, slot2, nst2, tok2, rowbase2);
        f32x4 stf[8], stb[8]; f32x2 segf = (f32x2){0.f, 0.f}, lowb = segf;
#pragma unroll
        for (int eb = 0; eb < 8; ++eb) { stf[eb] = (f32x4){0.f, 0.f, 0.f, 0.f}; stb[eb] = stf[eb]; }
        for (int k = 0; k < nst; k += 2) {
            const bool last = k + 2 >= nst;
            pa_load(rb, Z, rowbase, h, tok0 + (k + 1) * 128, wid, lane);
            pa_step(lds, ra, vr, stf, stb, segf, lowb, wid, lane, tid, Z, true, rowbase, h, tok0 + (k + 1) * 128);
            if (!last) pa_load(ra, Z, rowbase, h, tok0 + (k + 2) * 128, wid, lane);
            else if (more) pa_load(ra, Z, rowbase2, h2, tok2, wid, lane);
            pa_step(lds, rb, vr, stf, stb, segf, lowb, wid, lane, tid, Z, !last || more, last ? rowbase2 : rowbase, last ? h2 : h, last ? tok2 : tok0 + (k + 2) * 128);
        }
        const int chain = (b * 4 + h) * 2;
        float* Xf = SEG + ((size_t)chain * 9 + slot) * 16384 + (size_t)(wid * 64 + lane) * 32;
        float* Xb = SEG + ((size_t)(chain + 1) * 9 + slot) * 16384 + (size_t)(wid * 64 + lane) * 32;
#pragma unroll
        for (int eb = 0; eb < 8; ++eb) { *(GAS f32x4*)(Xf + 4 * eb) = stf[eb]; *(GAS f32x4*)(Xb + 4 * eb) = stb[eb]; }
        if (wid == 7) { *(GAS f32x2*)(SEGD + ((size_t)chain * 9 + slot) * 128 + d0) = (f32x2){exp2f(segf.x), exp2f(segf.y)};
                        *(GAS f32x2*)(SEGD + ((size_t)(chain + 1) * 9 + slot) * 128 + d0) = (f32x2){exp2f(lowb.x), exp2f(lowb.y)}; }
    }
    __syncthreads();
}

constexpr int OTP = 528;
__device__ __forceinline__ void hgrn_pass_c(LAS unsigned char* lds, int vcu, int G) {
    const bf16* Z = (const bf16*)(WS() + WS_Z); const float* SEG = (const float*)(WS() + WS_SEG); const float* SEGD = (const float*)(WS() + WS_SEGD);
    bf16* Y = (bf16*)(WS() + WS_Y); const float* nw = IN(9);
    int tid_ = threadIdx.x; asm volatile("" : "+v"(tid_)); const int tid = tid_, wid = __builtin_amdgcn_readfirstlane(tid >> 6), lane = tid & 63, fr = lane & 15, fq = lane >> 4, n = wid & 3, eh = wid >> 2;
    LAS float* NW = (LAS float*)(lds + L_SS);
    const int ep = tid >> 3, es = tid & 7;
    for (int u = vcu; u < 512; u += G) {
        const int b = u >> 5, h = (u >> 3) & 3, s = u & 7, tok0 = s * 512;
        bf16* OF = (bf16*)(WS() + WS_OF) + (size_t)u * 512 * 128;
        if (tid < 128) NW[tid] = nw[h * 128 + tid];
        for (int dir = 0; dir < 2; ++dir) {
            HgrnChain c{Z, b * SEQ, h, dir};
            const int chain = (b * 4 + h) * 2 + dir;
            f32x4 st[8], oacc[4]; float segsum[2] = {0.f, 0.f};
            if (dir == 0) hgrn_state_init(st, SEG, SEGD, chain, s, -1, s, wid, lane);
            else hgrn_state_init(st, SEG, SEGD, chain, s + 2, 1, 7 - s, wid, lane);
#pragma unroll
            for (int eb = 0; eb < 8; ++eb) { u32x2 w; w.x = cvt_pk_bf16(st[eb][0], st[eb][1]); w.y = cvt_pk_bf16(st[eb][2], st[eb][3]); *(LAS u32x2*)(lds + L_ST + (eb * 16 + fr) * HP + (16 * wid + 4 * fq) * 2) = w; }
            HgrnStep<true> pf; HgrnEpf epf; epf.on = (dir == 1);
            pf.prefetch(c, dir ? (tok0 + 7 * 64) : tok0, wid, lane, tid);
            for (int k = 0; k < 8; ++k) { const int kn = k + 1, c0 = tok0 + (dir ? (7 - k) : k) * 64, nc0 = tok0 + (dir ? (7 - kn) : kn) * 64;
                const int tl = dir ? (c0 - tok0 + 63 - ep) : (c0 - tok0 + ep);
                epf.ofp = OF + (size_t)tl * 128 + 16 * es; epf.zgp = Z + (size_t)(b * SEQ + tok0 + tl) * INC + C_G + h * 128 + 16 * es;
                hgrn_chunk<true>(lds, pf, st, oacc, segsum, c, nc0, kn < 8, epf, wid, lane, tid);
#pragma unroll
                for (int et = 0; et < 4; ++et)
#pragma unroll
                    for (int r = 0; r < 4; ++r) *(LAS float*)(lds + L_KH0 + (16 * n + 4 * fq + r) * OTP + (16 * (4 * eh + et) + fr) * 4) = oacc[et][r];
                WG_BAR();
                f32x4 o4[4];
#pragma unroll
                for (int j = 0; j < 4; ++j) o4[j] = *(const LAS f32x4*)(lds + L_KH0 + ep * OTP + (16 * es + 4 * j) * 4);
                if (dir == 0) {
                    u32x4 w0, w1;
                    w0.x = cvt_pk_bf16(o4[0][0], o4[0][1]); w0.y = cvt_pk_bf16(o4[0][2], o4[0][3]); w0.z = cvt_pk_bf16(o4[1][0], o4[1][1]); w0.w = cvt_pk_bf16(o4[1][2], o4[1][3]);
                    w1.x = cvt_pk_bf16(o4[2][0], o4[2][1]); w1.y = cvt_pk_bf16(o4[2][2], o4[2][3]); w1.z = cvt_pk_bf16(o4[3][0], o4[3][1]); w1.w = cvt_pk_bf16(o4[3][2], o4[3][3]);
                    *(GAS u32x4*)(OF + (size_t)tl * 128 + 16 * es) = w0; *(GAS u32x4*)(OF + (size_t)tl * 128 + 16 * es + 8) = w1;
                } else {
                    float ss = 0.f;
#pragma unroll
                    for (int j = 0; j < 4; ++j) { const u32x4 a = epf.of[j >> 1]; const unsigned lo = (j & 1) ? a.z : a.x, hi = (j & 1) ? a.w : a.y;
                        o4[j][0] += bf_lo(lo); o4[j][1] += bf_hi(lo); o4[j][2] += bf_lo(hi); o4[j][3] += bf_hi(hi);
                        ss += (o4[j][0] * o4[j][0] + o4[j][1] * o4[j][1]) + (o4[j][2] * o4[j][2] + o4[j][3] * o4[j][3]); }
                    ss = dpp_add<0xB1>(ss); ss = dpp_add<0x4E>(ss); ss = dpp_add<0x141>(ss);
                    const float rinv = 1.f / sqrtf(ss * (1.f / 128.f) + 1e-6f);
                    unsigned wo[8];
#pragma unroll
                    for (int j = 0; j < 4; ++j) { const u32x4 a = epf.zg[j >> 1]; const unsigned lo = (j & 1) ? a.z : a.x, hi = (j & 1) ? a.w : a.y;
                        const f32x4 g4 = *(const LAS f32x4*)(NW + 16 * es + 4 * j);
                        const float y0 = o4[j][0] * rinv * g4[0] * silu_f(bf_lo(lo)), y1 = o4[j][1] * rinv * g4[1] * silu_f(bf_hi(lo));
                        const float y2 = o4[j][2] * rinv * g4[2] * silu_f(bf_lo(hi)), y3 = o4[j][3] * rinv * g4[3] * silu_f(bf_hi(hi));
                        wo[2 * j] = cvt_pk_bf16(y0, y1); wo[2 * j + 1] = cvt_pk_bf16(y2, y3); }
                    bf16* yp = Y + (size_t)(b * SEQ + tok0 + tl) * DM + h * 128 + 16 * es;
                    *(GAS u32x4*)yp = (u32x4){wo[0], wo[1], wo[2], wo[3]}; *(GAS u32x4*)(yp + 8) = (u32x4){wo[4], wo[5], wo[6], wo[7]};
                }
            }
            VM_WAIT(); __syncthreads();
        }
    }
}
__device__ __forceinline__ void p6_ln1(int vcu, int G, int wave, int lane) {
    const float* mod = (const float*)(WS() + WS_CTL + CTL_MOD); bf16* H2 = (bf16*)(WS() + WS_H2); const bf16* R1 = (const bf16*)(WS() + WS_R1);
    const int gw = vcu * 8 + wave, NGW = G * 8, per = (T + NGW - 1) / NGW;
    int r0 = gw * per, r1 = r0 + per; if (r1 > T) r1 = T;
    f32x4 lw[4], lb[4];
#pragma unroll
    for (int j = 0; j < 4; ++j) { lw[j] = *(const GAS f32x4*)(IN(12) + 4 * lane + 256 * j); lb[j] = *(const GAS f32x4*)(IN(13) + 4 * lane + 256 * j); }
    int curb = -1; f32x4 sh[4], sc[4];
    for (int rb = r0; rb < r1; rb += 2) {
        const int b = rb >> 12;
        if (b != curb) { curb = b;
#pragma unroll
            for (int j = 0; j < 4; ++j) { sh[j] = *(const GAS f32x4*)(mod + b * 6144 + 3072 + 4 * lane + 256 * j); sc[j] = *(const GAS f32x4*)(mod + b * 6144 + 4096 + 4 * lane + 256 * j) + 1.f; } }
        f32x4 v[2][4]; float s[2], s2[2], mean[2], rstd[2];
#pragma unroll
        for (int q = 0; q < 2; ++q) { s[q] = 0.f;
#pragma unroll
            for (int j = 0; j < 4; ++j) { const u32x2 w = *(const GAS u32x2*)(R1 + (size_t)(rb + q) * DM + 4 * lane + 256 * j); v[q][j] = (f32x4){bf_lo(w.x), bf_hi(w.x), bf_lo(w.y), bf_hi(w.y)}; s[q] += (v[q][j].x + v[q][j].y) + (v[q][j].z + v[q][j].w); } }
#pragma unroll
        for (int q = 0; q < 2; ++q) mean[q] = wave_sum(s[q]) * (1.f / DM);
#pragma unroll
        for (int q = 0; q < 2; ++q) { s2[q] = 0.f;
#pragma unroll
            for (int j = 0; j < 4; ++j) { v[q][j] = v[q][j] - mean[q]; s2[q] += (v[q][j].x * v[q][j].x + v[q][j].y * v[q][j].y) + (v[q][j].z * v[q][j].z + v[q][j].w * v[q][j].w); } }
#pragma unroll
        for (int q = 0; q < 2; ++q) rstd[q] = 1.f / sqrtf(wave_sum(s2[q]) * (1.f / DM) + 1e-5f);
#pragma unroll
        for (int q = 0; q < 2; ++q) { s[q] = 0.f;
#pragma unroll
            for (int j = 0; j < 4; ++j) { v[q][j] = v[q][j] * rstd[q] * lw[j] + lb[j]; s[q] += (v[q][j].x + v[q][j].y) + (v[q][j].z + v[q][j].w); } }
#pragma unroll
        for (int q = 0; q < 2; ++q) mean[q] = wave_sum(s[q]) * (1.f / DM);
#pragma unroll
        for (int q = 0; q < 2; ++q) { s2[q] = 0.f;
#pragma unroll
            for (int j = 0; j < 4; ++j) { v[q][j] = v[q][j] - mean[q]; s2[q] += (v[q][j].x * v[q][j].x + v[q][j].y * v[q][j].y) + (v[q][j].z * v[q][j].z + v[q][j].w * v[q][j].w); } }
#pragma unroll
        for (int q = 0; q < 2; ++q) rstd[q] = 1.f / sqrtf(wave_sum(s2[q]) * (1.f / DM) + 1e-6f);
#pragma unroll
        for (int q = 0; q < 2; ++q) { bf16* o = H2 + (size_t)(rb + q) * DM;
#pragma unroll
            for (int j = 0; j < 4; ++j) { const f32x4 y = v[q][j] * rstd[q] * sc[j] + sh[j]; u32x2 w; w.x = cvt_pk_bf16(y.x, y.y); w.y = cvt_pk_bf16(y.z, y.w); *(GAS u32x2*)(o + 4 * lane + 256 * j) = w; } }
    }
}

__device__ __forceinline__ float rdlane(float x, int l) { return __int_as_float(__builtin_amdgcn_readlane(__float_as_int(x), l)); }
template <int CTRL> __device__ __forceinline__ float dpp_max(float x) { const int y = __builtin_amdgcn_update_dpp(__float_as_int(x), __float_as_int(x), CTRL, 0xF, 0xF, false); return fmaxf(x, __int_as_float(y)); }
__device__ __forceinline__ float group8_max(float x) { x = dpp_max<0xB1>(x); x = dpp_max<0x4E>(x); x = dpp_max<0x141>(x); return x; }
__device__ __forceinline__ float wave_max_u(float x) {
    x = group8_max(x); x = dpp_max<0x140>(x);
    const float a = rdlane(x, 0), b = rdlane(x, 16), c = rdlane(x, 32), d = rdlane(x, 48);
    return fmaxf(fmaxf(a, b), fmaxf(c, d));
}
constexpr int RWP = 1040;
__device__ __forceinline__ void p7_route(LAS unsigned char* lds, int vcu, int wave, int lane) {
    const bf16* H2 = (const bf16*)(WS() + WS_H2); const bf16* WR = (const bf16*)(WS() + WS_WR);
    int* TOKE = (int*)(WS() + WS_RT + RT_TOKE); float* TOKW = (float*)(WS() + WS_RT + RT_TOKW); int* TOKP = (int*)(WS() + WS_RT + RT_TOKP);
    unsigned* WGCNT = (unsigned*)(WS() + WS_CTL + CTL_WGCNT);
    LAS float* LG = (LAS float*)(lds + wave * 8448);
    LAS unsigned* CNT = (LAS unsigned*)(lds + 140000);
    int tid_ = threadIdx.x; asm volatile("" : "+v"(tid_)); const int tid = tid_, fr = lane & 15, fq = lane >> 4;
    if (tid < 64) CNT[tid] = 0u;
    const int r0 = vcu * 256 + wave * 32;
    f32x4 acc[2][4];
#pragma unroll
    for (int t = 0; t < 2; ++t)
#pragma unroll
        for (int et = 0; et < 4; ++et) acc[t][et] = (f32x4){0.f, 0.f, 0.f, 0.f};
    for (int kh = 0; kh < 2; ++kh) {
        __syncthreads();
#pragma unroll
        for (int i = 0; i < 16; ++i) { const int idx = tid + 512 * i, row = idx >> 6, ch = idx & 63;
            *(LAS u32x4*)(lds + row * RWP + ch * 16) = *(const GAS u32x4*)(WR + (size_t)row * DM + kh * 512 + ch * 8); }
        __syncthreads();
#pragma unroll 4
        for (int ks = 0; ks < 16; ++ks) {
            bf16x8 a[2];
#pragma unroll
            for (int t = 0; t < 2; ++t) a[t] = *(const GAS bf16x8*)(H2 + (size_t)(r0 + t * 16 + fr) * DM + kh * 512 + ks * 32 + fq * 8);
#pragma unroll
            for (int et = 0; et < 4; ++et) { const bf16x8 bh = *(const LAS bf16x8*)(lds + (et * 16 + fr) * RWP + ks * 64 + fq * 16), bl = *(const LAS bf16x8*)(lds + (64 + et * 16 + fr) * RWP + ks * 64 + fq * 16);
#pragma unroll
                for (int t = 0; t < 2; ++t) { acc[t][et] = MFMA16(a[t], bh, acc[t][et]); acc[t][et] = MFMA16(a[t], bl, acc[t][et]); } }
        }
    }
    __syncthreads();
    PSTAMP(lds, 43);
#pragma unroll
    for (int t = 0; t < 2; ++t)
#pragma unroll
        for (int et = 0; et < 4; ++et)
#pragma unroll
            for (int r = 0; r < 4; ++r) LG[(t * 16 + 4 * fq + r) * 65 + et * 16 + fr] = acc[t][et][r];
    __syncthreads();
    if (wave < 4) {
        const LAS float* L = (const LAS float*)(lds + (2 * wave + (lane >> 5)) * 8448) + (lane & 31) * 65;
        const float* biasp = IN(15);
        const int t = vcu * 256 + wave * 64 + lane;
        float sel[64];
#pragma unroll
        for (int e = 0; e < 64; ++e) sel[e] = fast_rcp(1.f + fast_exp(-L[e])) + biasp[e];
        float gs[8];
#pragma unroll
        for (int g = 0; g < 8; ++g) { float m1 = -INFINITY, m2 = -INFINITY;
#pragma unroll
            for (int j = 0; j < 8; ++j) { const float x = sel[8 * g + j]; m2 = fmaxf(m2, fminf(m1, x)); m1 = fmaxf(m1, x); }
            gs[g] = m1 + m2; }
#pragma unroll
        for (int g = 0; g < 8; ++g) { int cnt = 0;
#pragma unroll
            for (int q = 0; q < 8; ++q) if (q != g) cnt += ((gs[q] > gs[g]) || (gs[q] == gs[g] && q < g)) ? 1 : 0;
            const bool keep = cnt < 4;
#pragma unroll
            for (int j = 0; j < 8; ++j) sel[8 * g + j] = keep ? sel[8 * g + j] : -INFINITY; }
        int idx[8]; float sc[8]; float wsum = 0.f; int prev = -1;
#pragma unroll
        for (int k = 0; k < 8; ++k) { float best = -INFINITY; int bi = 0;
#pragma unroll
            for (int e = 0; e < 64; ++e) { if (k > 0) sel[e] = (prev == e) ? -INFINITY : sel[e]; const bool c = sel[e] > best; best = c ? sel[e] : best; bi = c ? e : bi; }
            idx[k] = bi; prev = bi; sc[k] = fast_rcp(1.f + fast_exp(-L[bi])); wsum += sc[k]; }
        int rk[8];
#pragma unroll
        for (int k = 0; k < 8; ++k) rk[k] = (int)atomicAdd((unsigned*)&CNT[idx[k]], 1u);
#pragma unroll
        for (int h = 0; h < 2; ++h) {
            *(GAS u32x4*)(TOKE + t * 8 + 4 * h) = (u32x4){(unsigned)idx[4 * h], (unsigned)idx[4 * h + 1], (unsigned)idx[4 * h + 2], (unsigned)idx[4 * h + 3]};
            *(GAS f32x4*)(TOKW + t * 8 + 4 * h) = (f32x4){sc[4 * h] / wsum * 2.5f, sc[4 * h + 1] / wsum * 2.5f, sc[4 * h + 2] / wsum * 2.5f, sc[4 * h + 3] / wsum * 2.5f};
            *(GAS u32x4*)(TOKP + t * 8 + 4 * h) = (u32x4){(unsigned)rk[4 * h], (unsigned)rk[4 * h + 1], (unsigned)rk[4 * h + 2], (unsigned)rk[4 * h + 3]}; }
    }
    __syncthreads();
    if (tid < 64) WGCNT[vcu * 64 + tid] = CNT[tid];
}

__device__ __forceinline__ void p8_scatter(LAS unsigned char* lds, int vcu, int wave, int lane) {
    int* TOKE = (int*)(WS() + WS_RT + RT_TOKE); int* TOKP = (int*)(WS() + WS_RT + RT_TOKP);
    int* SLOTTOK = (int*)(WS() + WS_RT + RT_SLOTTOK);
    const unsigned* WGCNT = (const unsigned*)(WS() + WS_CTL + CTL_WGCNT); int* GOFF = (int*)(WS() + WS_SMALL + 16384);
    LAS int* TOTL = (LAS int*)lds; LAS int* PRE = TOTL + 128; LAS int* GO = PRE + 128; LAS int* PT = GO + 160; LAS int* PP = PT + 512;
    int tid_ = threadIdx.x; asm volatile("" : "+v"(tid_)); const int tid = tid_, myh = vcu >> 7;
    { const int e = tid & 63, part = tid >> 6; int tot = 0, pre = 0;
#pragma unroll 8
      for (int w = 0; w < 32; ++w) { const int v = part * 32 + w; const int c = (int)WGCNT[v * 64 + e]; tot += c; pre += (v < vcu) ? c : 0; }
      PT[part * 64 + e] = tot; PP[part * 64 + e] = pre; }
    __syncthreads();
    if (tid < 128) { const int h = tid >> 6, e = tid & 63;
        TOTL[tid] = PT[(4 * h) * 64 + e] + PT[(4 * h + 1) * 64 + e] + PT[(4 * h + 2) * 64 + e] + PT[(4 * h + 3) * 64 + e];
        if (h == myh) PRE[e] = PP[(4 * h) * 64 + e] + PP[(4 * h + 1) * 64 + e] + PP[(4 * h + 2) * 64 + e] + PP[(4 * h + 3) * 64 + e]; }
    __syncthreads();
    if (tid < 2) { int off = 0; for (int e = 0; e < 64; ++e) { GO[tid * 66 + e] = off; off += (TOTL[tid * 64 + e] + 255) & ~255; } GO[tid * 66 + 64] = off; GO[tid * 66 + 65] = off + HALF_T; }
    __syncthreads();
    if (vcu == 0) {
        if (tid < 132) GOFF[tid] = GO[tid];
        if (tid < 128) { const int h = tid >> 6, e = tid & 63; const int beg = GO[h * 66 + e] + TOTL[tid], end = GO[h * 66 + e + 1];
            for (int s = beg; s < end; ++s) SLOTTOK[h * HCAP + s] = h * HALF_T; }
    }
    const int r0 = vcu * 256 + wave * 32;
#pragma unroll
    for (int it = 0; it < 4; ++it) { const int t = r0 + it * 8 + (lane >> 3), k = lane & 7;
        const int e = TOKE[t * 8 + k]; const int slot = GO[myh * 66 + e] + PRE[e] + TOKP[t * 8 + k];
        SLOTTOK[myh * HCAP + slot] = t; TOKP[t * 8 + k] = slot; }
    if (lane < 32) { const int t = r0 + lane; SLOTTOK[myh * HCAP + GO[myh * 66 + 64] + (t - myh * HALF_T)] = t; }
    __syncthreads();
}

template <int NN  , bool GATHER, int NG  >
struct GroupedOrder {
    const LAS int* GT; const char* A; const char* B; const int* sl; int G, c, K; size_t bgroup;
    __device__ __forceinline__ void init(LAS int* gt, const int* GOFF, int half, const void* A_, const void* B_, const int* slottok, int K_, size_t bgroup_bytes, int G_, int c_) {
        int tx = threadIdx.x; asm volatile("" : "+v"(tx));
        LAS int* szp = gt - 512;
        if ((int)tx < NG) { const int q = tx, h = (NG == 130) ? q / NE1 : half, e = q % NE1; const int g0 = GOFF[h * 66 + e], g1 = GOFF[h * 66 + e + 1];
            szp[q] = ((g1 - g0) >> 8) * NN; gt[132 + q] = h * HCAP + g0; }
        __syncthreads();
        if ((int)tx <= NG) { int cum = 0;
#pragma unroll 1
            for (int q = 0; q < (int)tx; ++q) cum += szp[q];
            gt[tx] = cum; }
        __syncthreads();
        if (tx < 32) { const int L = (int)tx * G_ + c_; int t0 = 0, t1 = 0, t2 = 0, t3 = 0;
            if (L < gt[NG]) { int lo = 0, hi = NG - 1;
#pragma unroll 1
                for (int it = 0; it < 8; ++it) if (lo < hi) { const int mid = (lo + hi + 1) >> 1; if (gt[mid] <= L) lo = mid; else hi = mid - 1; }
                const int local = L - gt[lo], mt = local / NN, nt = local - mt * NN;
                t0 = (gt[132 + lo] >> 8) + mt; t1 = nt; t2 = lo; t3 = 1; }
            *(LAS u32x4*)(gt + 272 + 4 * tx) = (u32x4){(unsigned)t0, (unsigned)t1, (unsigned)t2, (unsigned)t3}; }
        __syncthreads();
        GT = gt; A = (const char*)A_; B = (const char*)B_; sl = slottok; G = G_; c = c_; K = K_; bgroup = bgroup_bytes;
    }
    __device__ __forceinline__ bool next(int i, pg8::Unit& u) const {
#define RFL(x) __builtin_amdgcn_readfirstlane(x)
        if (i >= 32) return false;
        const u32x4 t = *(const LAS u32x4*)(GT + 272 + 4 * i);
        if (RFL((int)t.w) == 0) return false;
        const int q = RFL((int)t.z), nt = RFL((int)t.y), e = (q >= NE1) ? q - NE1 : q;
        u.pm = RFL((int)t.x); u.pn = nt; u.aux = q;
#undef RFL
        u.b = B + (size_t)e * bgroup + (size_t)nt * 256 * K * 2;
        if (GATHER) { u.a = A; u.gidx = sl + u.pm * 256; } else { u.a = A + (size_t)u.pm * 256 * K * 2; u.gidx = nullptr; }
        return true;
    }
};
struct EpiAct {
#ifdef EXP_DOUBLE_EPI
    static constexpr bool DOUBLE = (EXP_DOUBLE_EPI == 3);
#endif
    bf16* ACT;
    __device__ __forceinline__ void operator()(const acc_t& acc, const pg8::Unit& u, int wr, int wc, int fr, int fq) const {
        const int row0 = u.pm * 256 + wr * 64 + fr, col = u.pn * 128 + wc * 32 + 8 * fq;
#pragma unroll
        for (int ai = 0; ai < 2; ++ai)
#pragma unroll
            for (int m = 0; m < 4; ++m) { float o[8];
#pragma unroll
                for (int n = 0; n < 2; ++n)
#pragma unroll
                    for (int j = 0; j < 4; ++j) { const float gte = acc[ai][0][m][n][j]; o[4 * n + j] = gte * fast_rcp(1.f + fast_exp(-gte)) * acc[ai][1][m][n][j]; }
                u32x4 w; w.x = cvt_pk_bf16(o[0], o[1]); w.y = cvt_pk_bf16(o[2], o[3]); w.z = cvt_pk_bf16(o[4], o[5]); w.w = cvt_pk_bf16(o[6], o[7]);
                *(GAS u32x4*)((unsigned char*)ACT + ((unsigned)(row0 + ai * 128 + m * 16) * FF + (unsigned)col) * 2u) = w; }
    }
};
__device__ __forceinline__ unsigned pk4_fp8(f32x4 v) {
    v[0] = __builtin_amdgcn_fmed3f(v[0], -448.f, 448.f); v[1] = __builtin_amdgcn_fmed3f(v[1], -448.f, 448.f); v[2] = __builtin_amdgcn_fmed3f(v[2], -448.f, 448.f); v[3] = __builtin_amdgcn_fmed3f(v[3], -448.f, 448.f);
    int p = __builtin_amdgcn_cvt_pk_fp8_f32(v[0], v[1], 0, false); p = __builtin_amdgcn_cvt_pk_fp8_f32(v[2], v[3], p, true); return (unsigned)p; }
struct EpiDown {
#ifdef EXP_DOUBLE_EPI
    static constexpr bool DOUBLE = (EXP_DOUBLE_EPI == 4);
#endif
    unsigned char* SO; int rowbase;
    __device__ __forceinline__ void operator()(const acc_t& acc, const pg8::Unit& u, int wr, int wc, int fr, int fq) const {
        const int row0 = u.pm * 256 + wr * 64 + fr;
#pragma unroll
        for (int ai = 0; ai < 2; ++ai)
#pragma unroll
            for (int m = 0; m < 4; ++m) { const int row = row0 + ai * 128 + m * 16; const float g = 1.f;
                const unsigned a0 = pk4_fp8(acc[ai][0][m][0] * g), a1 = pk4_fp8(acc[ai][0][m][1] * g), b0 = pk4_fp8(acc[ai][1][m][0] * g), b1 = pk4_fp8(acc[ai][1][m][1] * g);
                const auto s0 = __builtin_amdgcn_permlane16_swap(a0, b0, false, false), s1 = __builtin_amdgcn_permlane16_swap(a1, b1, false, false);
                const u32x4 w = (u32x4){s0[0], s1[0], s0[1], s1[1]};
                *(GAS u32x4*)(SO + ((unsigned)(row - rowbase) * DM + (unsigned)(u.pn * 256 + (fq & 1) * 128 + wc * 32 + 8 * (fq & 2)))) = w; }
    }
};

__device__ __forceinline__ void p11_combine(int half, int vcu, int G, int wave, int lane_) {
    int lane = lane_; asm volatile("" : "+v"(lane));
    const float* mod = (const float*)(WS() + WS_CTL + CTL_MOD); const unsigned char* SO = (const unsigned char*)(WS() + WS_SO);
    const int* TOKP = (const int*)(WS() + WS_RT + RT_TOKP); const float* TOKW = (const float*)(WS() + WS_RT + RT_TOKW); const int* GOFF = (const int*)(WS() + WS_SMALL + 16384);
    const bf16* X1 = (const bf16*)(WS() + WS_R1); float* OUTP = OUT();
    const int gw = vcu * 8 + wave, NGW = G * 8, per = (HALF_T + NGW - 1) / NGW;
    int r0 = gw * per, r1 = r0 + per; if (r1 > HALF_T) r1 = HALF_T;
    const int shbase = GOFF[half * 66 + 64];
    f32x4 lw[4], lb[4], g2[4]; int curb = -1;
#pragma unroll
    for (int j = 0; j < 4; ++j) { const int col = 16 * lane + 4 * j; lw[j] = *(const GAS f32x4*)(IN(22) + col); lb[j] = *(const GAS f32x4*)(IN(23) + col); }
    f32x4 lw1[4], lb1[4];
#pragma unroll
    for (int j = 0; j < 4; ++j) { const int col = 16 * lane + 4 * j; lw1[j] = *(const GAS f32x4*)(IN(12) + col); lb1[j] = *(const GAS f32x4*)(IN(13) + col); }
    for (int rb = r0; rb < r1; rb += 2) {
        u32x4 raw[2][9], xw[2][2]; float gate[2];
#pragma unroll
        for (int q = 0; q < 2; ++q) { const int r = rb + q, t = half * HALF_T + r;
            const int slot = (lane < 8) ? TOKP[t * 8 + lane] : (shbase + r); gate[q] = (lane < 8) ? TOKW[t * 8 + lane] : 1.f;
#pragma unroll
            for (int k = 0; k < 9; ++k) { const int sk = __shfl(slot, k); raw[q][k] = *(const GAS u32x4*)(SO + (size_t)sk * DM + 16 * lane); }
            xw[q][0] = *(const GAS u32x4*)(X1 + (size_t)t * DM + 16 * lane); xw[q][1] = *(const GAS u32x4*)(X1 + (size_t)t * DM + 16 * lane + 8); }
#pragma unroll
        for (int q = 0; q < 2; ++q) { const int r = rb + q, t = half * HALF_T + r, b = t >> 12;
            if (b != curb) { curb = b;
#pragma unroll
                for (int j = 0; j < 4; ++j) g2[j] = *(const GAS f32x4*)(mod + b * 6144 + 5120 + 16 * lane + 4 * j) * (1.f / SO_SCALE); }
            float* xr = OUTP + (size_t)t * DM; f32x4 v[4];
            { const u32x4 a = xw[q][0], c = xw[q][1];
              v[0] = (f32x4){bf_lo(a.x), bf_hi(a.x), bf_lo(a.y), bf_hi(a.y)}; v[1] = (f32x4){bf_lo(a.z), bf_hi(a.z), bf_lo(a.w), bf_hi(a.w)};
              v[2] = (f32x4){bf_lo(c.x), bf_hi(c.x), bf_lo(c.y), bf_hi(c.y)}; v[3] = (f32x4){bf_lo(c.z), bf_hi(c.z), bf_lo(c.w), bf_hi(c.w)}; }
            { float s1 = 0.f;
#pragma unroll
              for (int j = 0; j < 4; ++j) s1 += (v[j].x + v[j].y) + (v[j].z + v[j].w);
              const float mean1 = wave_sum(s1) * (1.f / DM); float q1 = 0.f;
#pragma unroll
              for (int j = 0; j < 4; ++j) { v[j] = v[j] - mean1; q1 += (v[j].x * v[j].x + v[j].y * v[j].y) + (v[j].z * v[j].z + v[j].w * v[j].w); }
              const float rstd1 = 1.f / sqrtf(wave_sum(q1) * (1.f / DM) + 1e-5f);
#pragma unroll
              for (int j = 0; j < 4; ++j) v[j] = v[j] * rstd1 * lw1[j] + lb1[j]; }
            f32x4 y[4];
#pragma unroll
            for (int j = 0; j < 4; ++j) y[j] = (f32x4){0.f, 0.f, 0.f, 0.f};
#pragma unroll
            for (int k = 0; k < 9; ++k) { const float gk = __shfl(gate[q], k);
#pragma unroll
                for (int j = 0; j < 4; ++j) { const f32x2 a = __builtin_amdgcn_cvt_pk_f32_fp8((int)raw[q][k][j], false), c = __builtin_amdgcn_cvt_pk_f32_fp8((int)raw[q][k][j], true); y[j] += (f32x4){a.x, a.y, c.x, c.y} * gk; } }
            float s = 0.f;
#pragma unroll
            for (int j = 0; j < 4; ++j) { v[j] = v[j] * ALPHA + g2[j] * y[j]; s += (v[j].x + v[j].y) + (v[j].z + v[j].w); }
            const float mean = wave_sum(s) * (1.f / DM); float s2 = 0.f;
#pragma unroll
            for (int j = 0; j < 4; ++j) { v[j] = v[j] - mean; s2 += (v[j].x * v[j].x + v[j].y * v[j].y) + (v[j].z * v[j].z + v[j].w * v[j].w); }
            const float rstd = 1.f / sqrtf(wave_sum(s2) * (1.f / DM) + 1e-5f);
#pragma unroll
            for (int j = 0; j < 4; ++j) *(GAS f32x4*)(xr + 16 * lane + 4 * j) = v[j] * rstd * lw[j] + lb[j];
        }
    }
}
#ifndef MOE_ALIGN
#define MOE_ALIGN true
#endif
#ifndef PHMASK
#define PHMASK 0xffffffffu
#endif
#define PH(k) ((PHMASK >> (k)) & 1u)
#define CODE_SHIFT_STR_(x) #x
#define CODE_SHIFT_STR__(x) CODE_SHIFT_STR_(x)
#define CODE_SHIFT_STR CODE_SHIFT_STR__(CODE_SHIFT_NOPS)
#ifdef PROBE_A
constexpr bool P10_PEEL = false;
#else
constexpr bool P10_PEEL = true;
#endif
__global__ void __launch_bounds__(512, 2) mk_fwd(Ptrs P) {
    extern __shared__ __attribute__((aligned(16))) unsigned char lds_raw[];
    LAS unsigned char* lds = (LAS unsigned char*)lds_raw;
    const int tid = threadIdx.x, lane = tid & 63, wave = __builtin_amdgcn_readfirstlane(tid >> 6);
    const int G = gridDim.x; const int bx = blockIdx.x; const int vcu = (G % 8 == 0) ? (bx % 8) * (G / 8) + bx / 8 : bx;
    volatile LAS unsigned* MISC = (volatile LAS unsigned*)(lds + MISC_TOP);
    if (tid < 128) MISC[tid] = 0u;
    __syncthreads();
    unsigned char* ws = WS();
#ifdef PROBE_A
    volatile LAS unsigned long long* STP = (volatile LAS unsigned long long*)(lds + MISC_TOP + 64);
    int n_stamp = 0;
#define STAMP() do { if (blockIdx.x == 0 && threadIdx.x == 0 && n_stamp < 20) STP[n_stamp] = __builtin_amdgcn_s_memrealtime(); ++n_stamp; } while (0)
    STAMP();
#else
#define STAMP() do {} while (0)
#endif
    gu32* ctl = (gu32*)(ws + WS_CTL);
    XcdBarrier bar = xcd_barrier_post((unsigned*)(ctl + CW_BAR), MISC + 8);
(void)bar;
#define GRID_BAR() do { XcdBarrier b_; b_.bar = (unsigned*)(WS() + WS_CTL) + CW_BAR; b_.x = (unsigned)__builtin_amdgcn_readfirstlane((int)xb_xcc_id()); b_.st = (volatile LAS unsigned*)(lds + MISC_TOP) + 8; xcd_barrier(b_); STAMP(); } while (0)

#ifdef CODE_SHIFT_NOPS
    asm volatile(".rept " CODE_SHIFT_STR "\n\ts_nop 0\n\t.endr");
#endif
    if (PH(0)) { p0a_mod(lds, vcu, G, wave, lane); p0_prologue(lds, vcu, G, wave, lane); }
    GRID_BAR();
    if (PH(1)) { p1_mod_reduce(vcu, wave, lane); p1_modulate(lds, vcu, G, wave, lane); }
    GRID_BAR();
    if (PH(2)) { pg8::DenseOrder S; S.init(ws + WS_H, ws + WS_WIN, MALL, INC, DM, G, bx);
      EpiZ E{(bf16*)(ws + WS_Z), (const float*)(ws + WS_SMALL), (const f32x2*)(ws + WS_SMALL + 4096)};
      pg8::gemm_phase<EpiZ, pg8::DenseOrder, false>(lds, lds + GIDX_OFF, DM, S, E); }
    GRID_BAR();
    if (PH(3)) attn_phase(lds, vcu, G);
    PSTAMP(lds, 40);
    if (PH(4)) hgrn_pass_a(lds, vcu, G);
    PSTAMP(lds, 41);
    GRID_BAR();
    if (PH(5)) hgrn_pass_c(lds, vcu, G);
    GRID_BAR();
    if (PH(6)) { pg8::DenseOrder S; S.init(ws + WS_Y, ws + WS_WOUT, T, DM, DM, G, bx);
      EpiR1 E{IN(0), (const float*)(ws + WS_CTL + CTL_MOD), (bf16*)(ws + WS_R1)};
      pg8::gemm_phase<EpiR1, pg8::DenseOrder, false>(lds, lds + GIDX_OFF, DM, S, E); }
    GRID_BAR();
    if (PH(7)) p6_ln1(vcu, G, wave, lane);
    VM_WAIT(); __syncthreads();
    STAMP();
    if (PH(8)) p7_route(lds, vcu, wave, lane);
    PSTAMP(lds, 42);
    GRID_BAR();
    if (PH(9)) p8_scatter(lds, vcu, wave, lane);
    GRID_BAR();
    const int* GOFFp = (const int*)(ws + WS_SMALL + 16384);
    const int* sl_all = (const int*)(ws + WS_RT + RT_SLOTTOK);
    if (PH(10)) { GroupedOrder<2, true, 130> S; S.init((LAS int*)(lds + GTAB_OFF), GOFFp, 0, ws + WS_H2, ws + WS_WGU, sl_all, DM, (size_t)512 * DM * 2, G, vcu);
      EpiAct E{(bf16*)(ws + WS_ACT)};
      pg8::gemm_phase<EpiAct, GroupedOrder<2, true, 130>, true, MOE_ALIGN>(lds, lds + GIDX_OFF, DM, S, E); }
    GRID_BAR();
#pragma unroll
    for (int half = 0; half < 2; ++half) {
        if (PH(11)) { GroupedOrder<4, false, 65> S; S.init((LAS int*)(lds + GTAB_OFF), GOFFp, half, ws + WS_ACT, ws + WS_WD, sl_all, FF, (size_t)DM * FF * 2, G, vcu);
          EpiDown E{(unsigned char*)(ws + WS_SO), half * HCAP};
          pg8::gemm_phase<EpiDown, GroupedOrder<4, false, 65>, false, MOE_ALIGN, P10_PEEL>(lds, lds + GIDX_OFF, FF, S, E); }
        GRID_BAR();
        if (PH(12)) p11_combine(half, vcu, G, wave, lane);
        if (half == 0) GRID_BAR(); else STAMP();
    }
#ifdef PROBE_A
#ifndef PROBE_SCALE
#define PROBE_SCALE 1e-3f
#endif
#ifndef PROBE_OFF
#define PROBE_OFF 0
#endif
    GRID_BAR();
    if (blockIdx.x == 0) {
        const float v1 = 3.0f + (float)((long long)(STP[PROBE_A] - STP[PROBE_A0]) - (long long)(PROBE_OFF)) * PROBE_SCALE;
        float* o = OUT();
        if (threadIdx.x == 0) o[0] += v1;
#pragma unroll 1
        for (int i = threadIdx.x; i < 65536; i += 512) o[1024 + i] += 2.0f;
    }
#endif
}

extern "C" void kernel_launch(void* const* d_in, const int* in_sizes, int n_in, void* d_out, int out_size, void* d_ws, size_t ws_size, hipStream_t stream) {
    static int ready = 0;
    if (ready == 0) {
        if (n_in != 24 || in_sizes[0] != T * DM || out_size != T * DM || ws_size < WS_END) { fprintf(stderr, "kernel_launch: unexpected problem shape (n_in %d, in0 %d, out %d, ws %zu); nothing launched\n", n_in, n_in > 0 ? in_sizes[0] : -1, out_size, ws_size); ready = -1; return; }
        if (hipFuncSetAttribute((const void*)mk_fwd, hipFuncAttributeMaxDynamicSharedMemorySize, LDS_BYTES) != hipSuccess) { fprintf(stderr, "kernel_launch: hipFuncSetAttribute failed\n"); ready = -1; return; }
        int per_cu = 0;
        if (hipOccupancyMaxActiveBlocksPerMultiprocessor(&per_cu, (const void*)mk_fwd, 512, LDS_BYTES) != hipSuccess || per_cu < 1) fprintf(stderr, "kernel_launch: note: occupancy query reports %d workgroups per CU\n", per_cu);
        (void)hipGetLastError();
        ready = 1;
    }
    if (ready < 0) return;
    if (hipMemsetAsync((char*)d_ws + WS_CTL, 0, CTL_ZERO_BYTES, stream) != hipSuccess) { fprintf(stderr, "kernel_launch: memset failed\n"); return; }
    Ptrs p{};
    for (int i = 0; i < 24; ++i) p.in[i] = (const float*)d_in[i];
    p.out = (float*)d_out; p.ws = (unsigned char*)d_ws;
    hipLaunchKernelGGL(mk_fwd, dim3(256), dim3(512), LDS_BYTES, stream, p);
}
```

```cpp
#include <hip/hip_runtime.h>
#include <cstdio>
#include <cstdint>

#define LAS __attribute__((address_space(3)))
#define GAS __attribute__((address_space(1)))
typedef unsigned short bf16;
typedef short bf16x8 __attribute__((ext_vector_type(8)));
typedef short s16x4 __attribute__((ext_vector_type(4)));
typedef float f32x4 __attribute__((ext_vector_type(4)));
typedef float f32x2 __attribute__((ext_vector_type(2)));
typedef unsigned u32x4 __attribute__((ext_vector_type(4)));
typedef unsigned u32x2 __attribute__((ext_vector_type(2)));
typedef GAS unsigned gu32;

constexpr int NB = 16, SEQ = 4096, DM = 1024, CTXL = 256;
constexpr int T = NB * SEQ;
constexpr int TC = NB * CTXL;
constexpr int MALL = T + TC;
constexpr int INC = 3328;
constexpr int C_Q = 0, C_FF = 512, C_FB = 1024, C_I = 1536, C_G = 2048, C_AQ = 2560, C_AK = 3072, C_AV = 3200;
constexpr int NEXP = 64, NE1 = 65, FF = 256;
constexpr float ALPHA = 1.189207115002721f;
constexpr float LOG2E = 1.4426950408889634f;
constexpr float LOGF_MIN2 = -4.f * LOG2E;
constexpr float QSCALE = 0.125f * LOG2E;
constexpr int HALF_T = T / 2;
constexpr int HCAP = 311296;
constexpr int HTILES = HCAP / 256;

constexpr size_t MiB = 1u << 20;
constexpr size_t WS_CTL = 0, CTL_ZERO_BYTES = 1 * MiB;
constexpr size_t CTL_MOD = 65536;
constexpr size_t CTL_WGCNT = 524288;
constexpr size_t WS_SMALL = 1 * MiB;
constexpr size_t WS_WIN = 2 * MiB;
constexpr size_t WS_WOUT = 9 * MiB;
constexpr size_t WS_WR = 11 * MiB;
constexpr size_t WS_WGU = 12 * MiB;
constexpr size_t WS_WD = 77 * MiB;
constexpr size_t WS_H = 110 * MiB;
constexpr size_t WS_SEG = 110 * MiB;
constexpr size_t WS_SEGD = 183 * MiB;
constexpr size_t WS_OF = 184 * MiB;
constexpr size_t WS_Z = 250 * MiB;
constexpr size_t WS_Y = 692 * MiB;
constexpr size_t WS_R1 = 862 * MiB;
constexpr size_t WS_H2 = 110 * MiB;
constexpr size_t WS_RT = 238 * MiB;
constexpr size_t RT_TOKE = 0;
constexpr size_t RT_TOKW = 2 * MiB;
constexpr size_t RT_TOKP = 4 * MiB;
constexpr size_t RT_SLOTTOK = 6 * MiB;
constexpr size_t RT_SLOTW = 9 * MiB;
constexpr size_t WS_ACT = 254 * MiB;
constexpr size_t WS_SO = 558 * MiB;
constexpr size_t WS_MODP = 990 * MiB;
constexpr size_t WS_END = 997 * MiB;
constexpr float SO_SCALE = 32.f;

constexpr int CW_TMO = 0, CW_CODE = 1, CW_ERR = 2;
constexpr int CW_BAR = 4096;

constexpr int RING_BYTES = 131072;
constexpr int GIDX_OFF = RING_BYTES;
constexpr int GTAB_OFF = RING_BYTES + 2048;
constexpr int LDS_BYTES = 163840;
constexpr int MISC_TOP = LDS_BYTES - 512;
#ifdef PROBE_A
#define PSTAMP(lds, i) do { if (blockIdx.x == 0 && threadIdx.x == 0) ((volatile LAS unsigned long long*)((lds) + MISC_TOP + 64))[i] = __builtin_amdgcn_s_memrealtime(); } while (0)
#else
#define PSTAMP(lds, i) do {} while (0)
#endif

#define RLX_AGENT __ATOMIC_RELAXED, __HIP_MEMORY_SCOPE_AGENT
#define LDS_WAIT() asm volatile("s_waitcnt lgkmcnt(0)" ::: "memory")
#define VM_WAIT() asm volatile("s_waitcnt vmcnt(0)" ::: "memory")
#define WG_BAR() asm volatile("s_waitcnt lgkmcnt(0)\n\ts_barrier" ::: "memory")
__device__ __forceinline__ unsigned cvt_pk_bf16(float lo, float hi) { unsigned r; asm volatile("v_cvt_pk_bf16_f32 %0, %1, %2" : "=v"(r) : "v"(lo), "v"(hi)); return r; }
__device__ __forceinline__ float bf_lo(unsigned u) { return __uint_as_float(u << 16); }
__device__ __forceinline__ float bf_hi(unsigned u) { return __uint_as_float(u & 0xffff0000u); }
__device__ __forceinline__ float bf2f(bf16 h) { return __uint_as_float((unsigned)h << 16); }
__device__ __forceinline__ bf16 f2bf(float f) { return (bf16)(cvt_pk_bf16(f, 0.f) & 0xffffu); }
template <int CTRL> __device__ __forceinline__ float dpp_add(float x) { const int y = __builtin_amdgcn_update_dpp(0, __float_as_int(x), CTRL, 0xF, 0xF, false); return x + __int_as_float(y); }
__device__ __forceinline__ float wave_sum(float v) {
    v = dpp_add<0xB1>(v); v = dpp_add<0x4E>(v); v = dpp_add<0x141>(v); v = dpp_add<0x140>(v);
    const int b = __float_as_int(v);
    const float r0 = __int_as_float(__builtin_amdgcn_readlane(b, 0)), r1 = __int_as_float(__builtin_amdgcn_readlane(b, 16)), r2 = __int_as_float(__builtin_amdgcn_readlane(b, 32)), r3 = __int_as_float(__builtin_amdgcn_readlane(b, 48));
    return (r0 + r1) + (r2 + r3);
}
__device__ __forceinline__ float fast_exp2(float x) { return __builtin_amdgcn_exp2f(x); }
__device__ __forceinline__ float fast_exp(float x) { return __builtin_amdgcn_exp2f(x * LOG2E); }
__device__ __forceinline__ float fast_rcp(float x) { return __builtin_amdgcn_rcpf(x); }
__device__ __forceinline__ float silu_f(float v) { return v * fast_rcp(1.f + fast_exp(-v)); }
#define CAS __attribute__((address_space(4)))
__device__ __forceinline__ const float* IN(int i) { return ((const float* const CAS*)__builtin_amdgcn_kernarg_segment_ptr())[i]; }
__device__ __forceinline__ float* OUT() { return ((float* const CAS*)__builtin_amdgcn_kernarg_segment_ptr())[24]; }
__device__ __forceinline__ unsigned char* WS() { return ((unsigned char* const CAS*)__builtin_amdgcn_kernarg_segment_ptr())[25]; }
struct Ptrs { const float* in[24]; float* out; unsigned char* ws; };
namespace pg8 {
constexpr int BM = 256, BK = 64, HALF = 128, HTB = HALF * BK * 2, STAGE_BYTES = 8 * HTB, NXCD = 8, WGM = 8;
__host__ __device__ __forceinline__ int lds_byte(int r, int c) { const int st = (r >> 4) * 2 + (c >> 5), rr = r & 15, cc = c & 31, ob = rr * 64 + cc * 2; return st * 1024 + (ob ^ (((ob >> 9) & 1) << 5)); }
__host__ __device__ __forceinline__ void stage_rc(int b, int& R, int& C) { const int st = b / 1024, sb = b % 1024, swz = sb ^ (((sb >> 9) & 1) << 5); R = (st >> 1) * 16 + swz / 64; C = (st & 1) * 32 + (swz % 64) / 2; }
__host__ __device__ __forceinline__ int perm32(int rho) { const int n = rho >> 4, i = rho & 15; return 8 * (i >> 2) + 4 * n + (i & 3); }

struct Unit { const char* a; const char* b; const int* gidx; int pm, pn, aux; };

struct DenseOrder {
    const char* A; const char* Bt; int nM, nN, nwg, G, c, K;
    __device__ __forceinline__ void init(const void* A_, const void* Bt_, int M, int N, int K_, int G_, int c_) { A = (const char*)A_; Bt = (const char*)Bt_; nM = M / BM; nN = N / BM; nwg = nM * nN; G = G_; c = c_; K = K_; }
    __device__ __forceinline__ bool next(int i, Unit& u) const {
        const long L = (long)i * G + c; if (L >= nwg) return false;
        int wgid = (int)L; { const int q = nwg / NXCD, r = nwg % NXCD, xcd = wgid % NXCD, off = wgid / NXCD; wgid = (xcd < r ? xcd * (q + 1) : r * (q + 1) + (xcd - r) * q) + off; }
        const int nig = WGM * nN, gid = wgid / nig, fm = gid * WGM, gsz = (nM - fm) < WGM ? (nM - fm) : WGM;
        u.pm = fm + ((wgid % nig) % gsz); u.pn = (wgid % nig) / gsz; u.aux = 0; u.gidx = nullptr;
        u.a = A + (size_t)u.pm * BM * K * 2; u.b = Bt + (size_t)u.pn * BM * K * 2; return true;
    }
};

template <class Epi, class Sched, bool GATHER, bool ALIGN_EPI = true, bool PEEL = false>
__device__ __forceinline__ void gemm_phase(LAS unsigned char* lds, LAS unsigned char* gl, const int K, const Sched& S, const Epi& E) {
    int tid_ = threadIdx.x; asm volatile("" : "+v"(tid_));
    const int tid = tid_, wid = __builtin_amdgcn_readfirstlane(tid >> 6), lane = tid & 63, wr = wid >> 2, wc = wid & 3, fr = lane & 15, fq = lane >> 4;
    const int nt = K / BK;
    unsigned voffB[2], vC[2][2];
    const size_t hstep = (size_t)HALF * K * 2;
#pragma unroll
    for (int i = 0; i < 2; ++i) { int R, C; stage_rc(tid * 16 + i * 8192, R, C); const int Rb = (R & ~31) + perm32(R & 31);
        voffB[i] = (unsigned)(Rb * K + C) * 2u;
        vC[0][i] = (unsigned)(R * K + C) * 2u; vC[1][i] = vC[0][i] + (unsigned)hstep; }
    const size_t kstep = (size_t)(BK * 2);
    const unsigned ldsw = (unsigned)wid * 1024u;
    const int aoff = lds_byte(wr * 64 + fr, fq * 8), boff = lds_byte(wc * 32 + fr, fq * 8);
#define PG8_SA(b, h) (((b) * 2 + (h)) * HTB)
#define PG8_SB(b, h) ((4 + (b) * 2 + (h)) * HTB)
#define PG8_STAGE(bufoff, gbase, o0, o1) do { \
        __builtin_amdgcn_global_load_lds((const unsigned*)((const char*)(gbase) + (o0)), (LAS unsigned*)(lds + (bufoff) + ldsw), 16, 0, 0); \
        __builtin_amdgcn_global_load_lds((const unsigned*)((const char*)(gbase) + (o1)), (LAS unsigned*)(lds + (bufoff) + ldsw + 8192), 16, 0, 0); } while (0)
#define PG8_STAGEB(bufoff, gbase) PG8_STAGE(bufoff, gbase, voffB[0], voffB[1])
#define PG8_LDA(dst, b, h) do { _Pragma("unroll") for (int m = 0; m < 4; ++m) _Pragma("unroll") for (int k = 0; k < 2; ++k) dst[m][k] = *(const LAS bf16x8*)(lds + PG8_SA(b, h) + aoff + m * 2048 + k * 1024); } while (0)
#define PG8_LDB(dst, b, h) do { _Pragma("unroll") for (int n = 0; n < 2; ++n) _Pragma("unroll") for (int k = 0; k < 2; ++k) dst[n][k] = *(const LAS bf16x8*)(lds + PG8_SB(b, h) + boff + n * 2048 + k * 1024); } while (0)
#define PG8_MMA(ai, bj, At, Bt) do { __builtin_amdgcn_s_setprio(1); _Pragma("unroll") for (int m = 0; m < 4; ++m) _Pragma("unroll") for (int n = 0; n < 2; ++n) _Pragma("unroll") for (int k = 0; k < 2; ++k) \
        acc[ai][bj][m][n] = __builtin_amdgcn_mfma_f32_16x16x32_bf16(Bt[n][k], At[m][k], acc[ai][bj][m][n], 0, 0, 0); __builtin_amdgcn_s_setprio(0); } while (0)
#define PG8_MMA0(ai, bj, At, Bt) do { __builtin_amdgcn_s_setprio(1); _Pragma("unroll") for (int m = 0; m < 4; ++m) _Pragma("unroll") for (int n = 0; n < 2; ++n) { \
        acc[ai][bj][m][n] = __builtin_amdgcn_mfma_f32_16x16x32_bf16(Bt[n][0], At[m][0], (f32x4){0.f, 0.f, 0.f, 0.f}, 0, 0, 0); \
        acc[ai][bj][m][n] = __builtin_amdgcn_mfma_f32_16x16x32_bf16(Bt[n][1], At[m][1], acc[ai][bj][m][n], 0, 0, 0); } __builtin_amdgcn_s_setprio(0); } while (0)
#define PG8_WAIT_V(n) asm volatile("s_waitcnt vmcnt(" #n ")" ::: "memory")
#define PG8_WAIT_L(n) asm volatile("s_waitcnt lgkmcnt(" #n ")" ::: "memory")
#define PG8_BAR __builtin_amdgcn_s_barrier()
#define PG8_SCHED __builtin_amdgcn_sched_barrier(0)
    Unit cur, nxt; int ui = 0;
    if (!S.next(0, cur)) return;
    f32x4 acc[2][2][4][2];
    if constexpr (!PEEL) {
#pragma unroll
        for (int a = 0; a < 2; ++a)
#pragma unroll
            for (int b = 0; b < 2; ++b)
#pragma unroll
                for (int m = 0; m < 4; ++m)
#pragma unroll
                    for (int n = 0; n < 2; ++n) acc[a][b][m][n] = (f32x4){0.f, 0.f, 0.f, 0.f}; }
    bf16x8 At[4][2], B0[2][2], B1[2][2];
    const char* cA = cur.a; const char* cB = cur.b;
    if constexpr (GATHER) {
#pragma unroll
        for (int h = 0; h < 2; ++h)
#pragma unroll
            for (int i = 0; i < 2; ++i) { int R, C; stage_rc(tid * 16 + i * 8192, R, C); const int r = cur.gidx[h * HALF + R]; vC[h][i] = (unsigned)(r * K + C) * 2u; }
    }
    PG8_STAGEB(PG8_SB(0, 0), cB); PG8_STAGEB(PG8_SB(0, 1), cB + hstep); PG8_STAGE(PG8_SA(0, 0), cA, vC[0][0], vC[0][1]); PG8_STAGE(PG8_SA(0, 1), cA, vC[1][0], vC[1][1]);
    if (wr == 1) PG8_BAR;
    PG8_WAIT_V(2); PG8_BAR;
    PG8_STAGEB(PG8_SB(1, 0), cB + kstep); PG8_STAGE(PG8_SA(1, 0), cA + kstep, vC[0][0], vC[0][1]); PG8_STAGEB(PG8_SB(1, 1), cB + hstep + kstep);
    PG8_WAIT_V(6); PG8_BAR;
    for (;;) {
        const bool has_next = S.next(ui + 1, nxt);
        const char* nA = has_next ? nxt.a : cA; const char* nB = has_next ? nxt.b : cB;
        LAS unsigned char* gln = gl + ((ui + 1) & 1) * 1024;
        if constexpr (GATHER) { if (has_next && wid == 0) __builtin_amdgcn_global_load_lds((const unsigned*)(nxt.gidx + lane * 4), (LAS unsigned*)gln, 16, 0, 0); }
        if constexpr (PEEL) { const int t = 0;
            const bool last = false;
            const char* a1 = cA + (size_t)(t + 1) * kstep;
            const char* a2 = last ? nA : cA + (size_t)(t + 2) * kstep; const char* b2 = last ? nB : cB + (size_t)(t + 2) * kstep;
            const char* a3 = a2 + kstep; const char* b3 = b2 + kstep;
            asm volatile("" : "+s"(a1), "+s"(a2), "+s"(a3), "+s"(b2), "+s"(b3));
            unsigned w00 = vC[0][0], w01 = vC[0][1], w10 = vC[1][0], w11 = vC[1][1];
            unsigned ob0 = voffB[0], ob1 = voffB[1], obh0 = voffB[0] + (unsigned)hstep, obh1 = voffB[1] + (unsigned)hstep, oc10 = vC[1][0], oc11 = vC[1][1];
            asm volatile("" : "+v"(ob0), "+v"(ob1), "+v"(obh0), "+v"(obh1), "+v"(oc10), "+v"(oc11), "+v"(w00), "+v"(w01), "+v"(w10), "+v"(w11));
            if constexpr (GATHER) { if (last && has_next) {
#pragma unroll
                for (int i = 0; i < 2; ++i) { int R, C; stage_rc(tid * 16 + i * 8192, R, C); const int ra = ((const LAS int*)gln)[R], rb = ((const LAS int*)gln)[HALF + R];
                    const unsigned oa = (unsigned)(ra * K + C) * 2u, ob = (unsigned)(rb * K + C) * 2u; if (i == 0) { w00 = oa; w10 = ob; } else { w01 = oa; w11 = ob; } } } }
            PG8_LDB(B0, 0, 0); PG8_LDB(B1, 0, 1); PG8_SCHED; PG8_LDA(At, 0, 0); PG8_STAGE(PG8_SA(1, 1), a1, oc10, oc11);
            PG8_WAIT_V(8); PG8_WAIT_L(0); PG8_BAR; PG8_MMA0(0, 0, At, B0); PG8_MMA0(0, 1, At, B1); PG8_BAR; PG8_SCHED;
            PG8_LDA(At, 0, 1); PG8_STAGE(PG8_SB(0, 0), b2, ob0, ob1); PG8_STAGE(PG8_SB(0, 1), b2, obh0, obh1); PG8_STAGE(PG8_SA(0, 0), a2, w00, w01);
            PG8_WAIT_V(8); PG8_WAIT_L(0); PG8_BAR; PG8_MMA0(1, 0, At, B0); PG8_MMA0(1, 1, At, B1); PG8_BAR; PG8_SCHED;
            PG8_LDB(B0, 1, 0); PG8_LDB(B1, 1, 1); PG8_SCHED; PG8_LDA(At, 1, 0); PG8_STAGE(PG8_SA(0, 1), a2, w10, w11);
            PG8_WAIT_V(8); PG8_WAIT_L(0); PG8_BAR; PG8_MMA(0, 0, At, B0); PG8_MMA(0, 1, At, B1); PG8_BAR; PG8_SCHED;
            PG8_LDA(At, 1, 1); PG8_STAGE(PG8_SB(1, 0), b3, ob0, ob1); PG8_STAGE(PG8_SB(1, 1), b3, obh0, obh1); PG8_STAGE(PG8_SA(1, 0), a3, w00, w01);
            PG8_WAIT_V(8); PG8_WAIT_L(0); PG8_BAR; PG8_MMA(1, 0, At, B0); PG8_MMA(1, 1, At, B1); PG8_BAR; PG8_SCHED;
        }
#pragma unroll 1
        for (int t = PEEL ? 2 : 0; t < nt; t += 2) {
            const bool last = (t == nt - 2);
            const char* a1 = cA + (size_t)(t + 1) * kstep;
            const char* a2 = last ? nA : cA + (size_t)(t + 2) * kstep; const char* b2 = last ? nB : cB + (size_t)(t + 2) * kstep;
            const char* a3 = a2 + kstep; const char* b3 = b2 + kstep;
            asm volatile("" : "+s"(a1), "+s"(a2), "+s"(a3), "+s"(b2), "+s"(b3));
            unsigned w00 = vC[0][0], w01 = vC[0][1], w10 = vC[1][0], w11 = vC[1][1];
            unsigned ob0 = voffB[0], ob1 = voffB[1], obh0 = voffB[0] + (unsigned)hstep, obh1 = voffB[1] + (unsigned)hstep, oc10 = vC[1][0], oc11 = vC[1][1];
            asm volatile("" : "+v"(ob0), "+v"(ob1), "+v"(obh0), "+v"(obh1), "+v"(oc10), "+v"(oc11), "+v"(w00), "+v"(w01), "+v"(w10), "+v"(w11));
            if constexpr (GATHER) { if (last && has_next) {
#pragma unroll
                for (int i = 0; i < 2; ++i) { int R, C; stage_rc(tid * 16 + i * 8192, R, C); const int ra = ((const LAS int*)gln)[R], rb = ((const LAS int*)gln)[HALF + R];
                    const unsigned oa = (unsigned)(ra * K + C) * 2u, ob = (unsigned)(rb * K + C) * 2u; if (i == 0) { w00 = oa; w10 = ob; } else { w01 = oa; w11 = ob; } } } }
            PG8_LDB(B0, 0, 0); PG8_LDB(B1, 0, 1); PG8_SCHED; PG8_LDA(At, 0, 0); PG8_STAGE(PG8_SA(1, 1), a1, oc10, oc11);
            PG8_WAIT_V(8); PG8_WAIT_L(0); PG8_BAR; PG8_MMA(0, 0, At, B0); PG8_MMA(0, 1, At, B1); PG8_BAR; PG8_SCHED;
            PG8_LDA(At, 0, 1); PG8_STAGE(PG8_SB(0, 0), b2, ob0, ob1); PG8_STAGE(PG8_SB(0, 1), b2, obh0, obh1); PG8_STAGE(PG8_SA(0, 0), a2, w00, w01);
            PG8_WAIT_V(8); PG8_WAIT_L(0); PG8_BAR; PG8_MMA(1, 0, At, B0); PG8_MMA(1, 1, At, B1); PG8_BAR; PG8_SCHED;
            PG8_LDB(B0, 1, 0); PG8_LDB(B1, 1, 1); PG8_SCHED; PG8_LDA(At, 1, 0); PG8_STAGE(PG8_SA(0, 1), a2, w10, w11);
            PG8_WAIT_V(8); PG8_WAIT_L(0); PG8_BAR; PG8_MMA(0, 0, At, B0); PG8_MMA(0, 1, At, B1); PG8_BAR; PG8_SCHED;
            PG8_LDA(At, 1, 1); PG8_STAGE(PG8_SB(1, 0), b3, ob0, ob1); PG8_STAGE(PG8_SB(1, 1), b3, obh0, obh1); PG8_STAGE(PG8_SA(1, 0), a3, w00, w01);
            PG8_WAIT_V(8); PG8_WAIT_L(0); PG8_BAR; PG8_MMA(1, 0, At, B0); PG8_MMA(1, 1, At, B1); PG8_BAR; PG8_SCHED;
        }
        if constexpr (ALIGN_EPI) { if (wr == 0) PG8_BAR; }
        E(acc, cur, wr, wc, fr, fq);
#ifdef EXP_DOUBLE_EPI
        if (Epi::DOUBLE) { asm volatile("" ::: "memory"); E(acc, cur, wr, wc, fr, fq); }
#endif
        if (!has_next) break;
        if constexpr (!PEEL) {
#pragma unroll
            for (int a = 0; a < 2; ++a)
#pragma unroll
                for (int b = 0; b < 2; ++b)
#pragma unroll
                    for (int m = 0; m < 4; ++m)
#pragma unroll
                        for (int n = 0; n < 2; ++n) acc[a][b][m][n] = (f32x4){0.f, 0.f, 0.f, 0.f}; }
        cur = nxt; cA = nA; cB = nB; ++ui;
        if constexpr (GATHER) {
#pragma unroll
            for (int i = 0; i < 2; ++i) { int R, C; stage_rc(tid * 16 + i * 8192, R, C); const int ra = ((const LAS int*)gln)[R], rb = ((const LAS int*)gln)[HALF + R];
                vC[0][i] = (unsigned)(ra * K + C) * 2u; vC[1][i] = (unsigned)(rb * K + C) * 2u; } }
        if constexpr (ALIGN_EPI) { if (wr == 1) PG8_BAR; }
    }
    PG8_WAIT_V(0);
    if constexpr (!ALIGN_EPI) { if (wr == 0) PG8_BAR; }
    PG8_BAR;
#undef PG8_SA
#undef PG8_SB
#undef PG8_STAGE
#undef PG8_STAGEB
#undef PG8_LDA
#undef PG8_LDB
#undef PG8_MMA
#undef PG8_MMA0
#undef PG8_WAIT_V
#undef PG8_WAIT_L
#undef PG8_BAR
#undef PG8_SCHED
}
}
#define XB_TMO      128
#define XB_XCNT(j)  (256  + 64 * (j))
#define XB_XSUB(j)  (1280 + 64 * (j))
#define XB_XGEN(j)  (2304 + 64 * (j))
#define XB_TOP      3328
#define XB_TOPGEN   3392
#define XCD_BAR_WORDS 3456
#define XB_SPIN_CAP (1u << 18)

__device__ __forceinline__ unsigned xb_ld(unsigned* p)              { return __hip_atomic_load(p, __ATOMIC_RELAXED, __HIP_MEMORY_SCOPE_AGENT); }
__device__ __forceinline__ unsigned xb_add(unsigned* p, unsigned v) { return __hip_atomic_fetch_add(p, v, __ATOMIC_RELAXED, __HIP_MEMORY_SCOPE_AGENT); }
__device__ __forceinline__ unsigned xb_xcc_id() { return (unsigned)__builtin_amdgcn_s_getreg((3 << 11) | 20) & 0xFu; }
#define XB_SPIN(cond, bar) do { unsigned _sp = 0; while (cond) { __builtin_amdgcn_s_sleep(1); \
    if ((++_sp & 255u) == 0u) { if (xb_ld(&(bar)[XB_TMO])) break; if (_sp > XB_SPIN_CAP) { atomicAdd(&(bar)[XB_TMO], 1u); break; } } } } while (0)

struct XcdBarrier {
    unsigned* bar; unsigned x;
    volatile LAS unsigned* st;
};

__device__ __forceinline__ XcdBarrier xcd_barrier_post(unsigned* bar, volatile LAS unsigned* st) {
    XcdBarrier b; b.bar = bar; b.x = xb_xcc_id(); b.st = st;
    if (threadIdx.x == 0) (void)xb_add(&bar[XB_XCNT(b.x)], 1u);
    return b;
}
__device__ __forceinline__ void xcd_barrier_complete(unsigned* bar, unsigned x, unsigned& nloc, unsigned& nx) {
    const unsigned G = gridDim.x * gridDim.y * gridDim.z;
    unsigned sum, cnt, mine, sp = 0u;
    for (;;) {
        sum = 0u; cnt = 0u; mine = 0u;
#pragma unroll
        for (unsigned j = 0; j < 16; ++j) { const unsigned c = xb_ld(&bar[XB_XCNT(j)]); sum += c; cnt += (c > 0u) ? 1u : 0u; mine = (j == x) ? c : mine; }
        if (sum == G) break;
        __builtin_amdgcn_s_sleep(1);
        if ((++sp & 255u) == 0u) { if (xb_ld(&bar[XB_TMO])) break; if (sp > XB_SPIN_CAP) { atomicAdd(&bar[XB_TMO], 1u); break; } }
    }
    nloc = mine > 0u ? mine : 1u; nx = cnt > 0u ? cnt : 1u;
}

__device__ __forceinline__ void xcd_barrier(const XcdBarrier& b) {
    asm volatile("s_waitcnt vmcnt(0)" ::: "memory");
    __syncthreads();
    if (threadIdx.x == 0) {
        unsigned* bar = b.bar;
        __builtin_amdgcn_s_waitcnt(0);
        unsigned nloc = b.st[0], nx = b.st[1];
        if (nloc == 0u) { xcd_barrier_complete(bar, b.x, nloc, nx); b.st[0] = nloc; b.st[1] = nx; }
        const unsigned old = xb_add(&bar[XB_XSUB(b.x)], 1u);
        const unsigned gen = old / nloc;
        if (old + 1u == (gen + 1u) * nloc) {
            __builtin_amdgcn_fence(__ATOMIC_RELEASE, "agent");
            asm volatile("s_waitcnt vmcnt(0)" ::: "memory");
            const unsigned og = xb_add(&bar[XB_TOP], 1u);
            const unsigned tg = og / nx;
            if (og + 1u == (tg + 1u) * nx) xb_add(&bar[XB_TOPGEN], 1u);
            else XB_SPIN(xb_ld(&bar[XB_TOPGEN]) == tg, bar);
            __builtin_amdgcn_fence(__ATOMIC_ACQUIRE, "agent");
            xb_add(&bar[XB_XGEN(b.x)], 1u);
            asm volatile("s_waitcnt vmcnt(0)" ::: "memory");
        } else {
            XB_SPIN(xb_ld(&bar[XB_XGEN(b.x)]) == gen, bar);
            __builtin_amdgcn_fence(__ATOMIC_ACQUIRE, "agent");
            asm volatile("s_waitcnt vmcnt(0)" ::: "memory");
        }
    }
    __syncthreads();
}
__device__ __forceinline__ void p0_transpose_item(const float* W, int K, int N, bf16* WT, bf16* WTlo, int mode, LAS float* scr, int item, int lane) {
    const int nblk = N / 32, kb = item / nblk, nb = item % nblk, k0 = 64 * kb, n0 = 32 * nb;
#pragma unroll
    for (int i = 0; i < 8; ++i) { const int kk = 8 * i + (lane >> 3), c4 = 4 * (lane & 7); const f32x4 v = *(const GAS f32x4*)(W + (size_t)(k0 + kk) * N + n0 + c4);
        scr[kk * 33 + c4] = v.x; scr[kk * 33 + c4 + 1] = v.y; scr[kk * 33 + c4 + 2] = v.z; scr[kk * 33 + c4 + 3] = v.w; }
    LDS_WAIT(); asm volatile("" ::: "memory");
    const int rowbase = (mode == 0 || mode == 3) ? n0 : ((n0 >> 7) * 256 + (n0 & 127) + (mode == 2 ? 128 : 0));
    const float wsc = (mode == 3) ? SO_SCALE : 1.f;
    const int c = lane & 7;
#pragma unroll
    for (int j = 0; j < 4; ++j) { const int n = (lane >> 3) + 8 * j; const LAS float* s = scr + (8 * c) * 33 + n;
        float v[8];
#pragma unroll
        for (int q = 0; q < 8; ++q) v[q] = s[q * 33] * wsc;
        u32x4 o; o.x = cvt_pk_bf16(v[0], v[1]); o.y = cvt_pk_bf16(v[2], v[3]); o.z = cvt_pk_bf16(v[4], v[5]); o.w = cvt_pk_bf16(v[6], v[7]);
        *(GAS u32x4*)(WT + (size_t)(rowbase + n) * K + k0 + 8 * c) = o;
        if (WTlo) { u32x4 l; l.x = cvt_pk_bf16(v[0] - bf_lo(o.x), v[1] - bf_hi(o.x)); l.y = cvt_pk_bf16(v[2] - bf_lo(o.y), v[3] - bf_hi(o.y));
            l.z = cvt_pk_bf16(v[4] - bf_lo(o.z), v[5] - bf_hi(o.z)); l.w = cvt_pk_bf16(v[6] - bf_lo(o.w), v[7] - bf_hi(o.w));
            *(GAS u32x4*)(WTlo + (size_t)(rowbase + n) * K + k0 + 8 * c) = l; } }
    LDS_WAIT(); asm volatile("" ::: "memory");
}
__device__ __forceinline__ void p0_mod_task(const float* c, const float* c_ctx, const float* w_ada, const float* b_ada, float* mod, LAS float* scr, int task, int lane) {
    const int cg = task % 24, kc = task / 24, k0 = kc * 64, j0 = cg * 256 + lane * 4;
    for (int idx = lane; idx < 17 * 64; idx += 64) { const int r = idx >> 6, kk = idx & 63; const float v = (r < 16) ? c[r * DM + k0 + kk] : c_ctx[k0 + kk]; scr[idx] = v / (1.f + expf(-v)); }
    LDS_WAIT(); asm volatile("" ::: "memory");
    f32x4 acc[17];
#pragma unroll
    for (int r = 0; r < 17; ++r) acc[r] = (f32x4){0.f, 0.f, 0.f, 0.f};
#pragma unroll 4
    for (int kk = 0; kk < 64; ++kk) { const f32x4 w = *(const GAS f32x4*)(w_ada + (size_t)(k0 + kk) * 6144 + j0);
#pragma unroll
        for (int r = 0; r < 17; ++r) acc[r] += w * scr[r * 64 + kk]; }
    if (kc == 0) { const f32x4 b = *(const GAS f32x4*)(b_ada + j0);
#pragma unroll
        for (int r = 0; r < 17; ++r) acc[r] += b; }
#pragma unroll
    for (int r = 0; r < 17; ++r) *(GAS f32x4*)(mod + ((size_t)kc * 17 + r) * 6144 + j0) = acc[r];
    LDS_WAIT(); asm volatile("" ::: "memory");
}


__device__ __forceinline__ void p0a_mod(LAS unsigned char* lds, int vcu, int G, int wave, int lane) {
    LAS float* scr = (LAS float*)(lds + wave * 16384);
    unsigned char* ws = WS();
    const int gw0 = wave * G + vcu;
    if (gw0 < 384) p0_mod_task(IN(1), IN(3), IN(4), IN(5), (float*)(ws + WS_MODP), scr, gw0, lane);
    if (wave == 2 && (int)blockIdx.x == 200) {
        float* LB = (float*)(ws + WS_SMALL);
        for (int d = lane; d < 512; d += 64) { LB[d] = 1.f / (1.f + expf(IN(7)[512 + d] - IN(7)[d])); LB[512 + d] = 1.f / (1.f + expf(IN(8)[512 + d] - IN(8)[d])); }
    }
    if (wave == 2 && (int)blockIdx.x == 201) {
        f32x2* RT = (f32x2*)(ws + WS_SMALL + 4096);
        for (int e = lane; e < 1024; e += 64) { const int pos = e >> 4, i = e & 15; const double fr = pow(10000.0, -(double)i / 16.0), a = (double)pos * fr; RT[e] = (f32x2){(float)cos(a), (float)sin(a)}; }
    }
}
__device__ __forceinline__ void p0_prologue(LAS unsigned char* lds, int vcu, int G, int wave, int lane) {
    LAS float* scr = (LAS float*)(lds + wave * 16384);
    unsigned char* ws = WS();
    const int gw = vcu * 8 + wave, NGW = G * 8;
    constexpr int I_IN = 16 * 104, I_OUT = 16 * 32, I_E = 128, I_R = 32;
    constexpr int NITEMS = I_IN + I_OUT + NE1 * 3 * I_E + I_R;
    for (int it = gw; it < NITEMS; it += NGW) {
        int r = it;
        if (r < I_IN) { p0_transpose_item(IN(6), DM, INC, (bf16*)(ws + WS_WIN), nullptr, 0, scr, r, lane); continue; } r -= I_IN;
        if (r < I_OUT) { p0_transpose_item(IN(11), DM, DM, (bf16*)(ws + WS_WOUT), nullptr, 0, scr, r, lane); continue; } r -= I_OUT;
        if (r < NE1 * 3 * I_E) { const int e = r / (3 * I_E), q = r % (3 * I_E), typ = q / I_E, item = q % I_E;
            if (typ < 2) { const float* src = (e < NEXP) ? IN(16 + typ) + (size_t)e * DM * FF : IN(19 + typ);
                p0_transpose_item(src, DM, FF, (bf16*)(ws + WS_WGU) + (size_t)e * 512 * DM, nullptr, 1 + typ, scr, item, lane); }
            else { const float* src = (e < NEXP) ? IN(18) + (size_t)e * FF * DM : IN(21);
                p0_transpose_item(src, FF, DM, (bf16*)(ws + WS_WD) + (size_t)e * DM * FF, nullptr, 3, scr, item, lane); }
            continue; } r -= NE1 * 3 * I_E;
        p0_transpose_item(IN(14), DM, NEXP, (bf16*)(ws + WS_WR), (bf16*)(ws + WS_WR) + NEXP * DM, 0, scr, r, lane);
    }
}

__device__ __forceinline__ void p1_mod_reduce(int vcu, int wave, int lane) {
    if (wave == 7 && vcu < 136) { const float* modp = (const float*)(WS() + WS_MODP); float* mod = (float*)(WS() + WS_CTL + CTL_MOD);
        const int r = vcu >> 3, c0 = (vcu & 7) * 768;
#pragma unroll
        for (int i = 0; i < 3; ++i) { const int j = c0 + i * 256 + lane * 4; f32x4 a = (f32x4){0.f, 0.f, 0.f, 0.f};
#pragma unroll
            for (int kc = 0; kc < 16; ++kc) a += *(const GAS f32x4*)(modp + ((size_t)kc * 17 + r) * 6144 + j);
            *(GAS f32x4*)(mod + r * 6144 + j) = a; } }
}
__device__ __forceinline__ void p1_modulate(LAS unsigned char* lds, int vcu, int G, int wave, int lane) {
    const float* modp = (const float*)(WS() + WS_MODP); bf16* H = (bf16*)(WS() + WS_H);
    const int gw = vcu * 8 + wave, NGW = G * 8, per = (MALL + NGW - 1) / NGW;
    LAS float* MS = (LAS float*)lds;
    const int wr0 = vcu * 8 * per, wr1 = (wr0 + 8 * per - 1 < MALL - 1) ? wr0 + 8 * per - 1 : MALL - 1;
    const int bA = (wr0 < T) ? (wr0 >> 12) : 16, bB = (wr1 < T) ? (wr1 >> 12) : 16;
    { const int tid = threadIdx.x, which = tid >> 8, c8 = (tid & 255) * 8, bb = which ? bB : bA;
      f32x4 a0 = (f32x4){0.f, 0.f, 0.f, 0.f}, a1 = a0;
#pragma unroll 4
      for (int kc = 0; kc < 16; ++kc) { const float* pr = modp + ((size_t)kc * 17 + bb) * 6144 + c8; a0 += *(const GAS f32x4*)pr; a1 += *(const GAS f32x4*)(pr + 4); }
      *(LAS f32x4*)(MS + which * 2048 + c8) = a0; *(LAS f32x4*)(MS + which * 2048 + c8 + 4) = a1; }
    __syncthreads();
    int r0 = gw * per, r1 = r0 + per; if (r1 > MALL) r1 = MALL;
    int curb = -1; f32x4 sh[4], sc[4];
    for (int rb = r0; rb < r1; rb += 2) {
        const int b = (rb < T) ? (rb >> 12) : 16;
        if (b != curb) { curb = b; const LAS float* ms = MS + ((b == bA) ? 0 : 2048);
#pragma unroll
            for (int j = 0; j < 4; ++j) { sh[j] = *(const LAS f32x4*)(ms + 4 * lane + 256 * j); sc[j] = *(const LAS f32x4*)(ms + 1024 + 4 * lane + 256 * j) + 1.f; } }
        f32x4 v[2][4]; float s[2], s2[2], mean[2], rstd[2];
#pragma unroll
        for (int q = 0; q < 2; ++q) { const int r = rb + q; const float* src = (r < T) ? IN(0) + (size_t)r * DM : IN(2) + (size_t)(r - T) * DM; s[q] = 0.f;
#pragma unroll
            for (int j = 0; j < 4; ++j) { v[q][j] = *(const GAS f32x4*)(src + 4 * lane + 256 * j); s[q] += (v[q][j].x + v[q][j].y) + (v[q][j].z + v[q][j].w); } }
#pragma unroll
        for (int q = 0; q < 2; ++q) mean[q] = wave_sum(s[q]) * (1.f / DM);
#pragma unroll
        for (int q = 0; q < 2; ++q) { s2[q] = 0.f;
#pragma unroll
            for (int j = 0; j < 4; ++j) { v[q][j] = v[q][j] - mean[q]; s2[q] += (v[q][j].x * v[q][j].x + v[q][j].y * v[q][j].y) + (v[q][j].z * v[q][j].z + v[q][j].w * v[q][j].w); } }
#pragma unroll
        for (int q = 0; q < 2; ++q) rstd[q] = 1.f / sqrtf(wave_sum(s2[q]) * (1.f / DM) + 1e-6f);
#pragma unroll
        for (int q = 0; q < 2; ++q) { bf16* o = H + (size_t)(rb + q) * DM;
#pragma unroll
            for (int j = 0; j < 4; ++j) { const f32x4 y = v[q][j] * rstd[q] * sc[j] + sh[j]; u32x2 w; w.x = cvt_pk_bf16(y.x, y.y); w.y = cvt_pk_bf16(y.z, y.w); *(GAS u32x2*)(o + 4 * lane + 256 * j) = w; } }
    }
}

typedef f32x4 acc_t[2][2][4][2];
struct EpiZ {
#ifdef EXP_DOUBLE_EPI
    static constexpr bool DOUBLE = (EXP_DOUBLE_EPI == 1);
#endif
    bf16* Z; const float* LB; const f32x2* RT;
    __device__ __forceinline__ void operator()(const acc_t& acc, const pg8::Unit& u, int wr, int wc, int fr, int fq) const {
        const int row0 = u.pm * 256 + wr * 64 + fr, pn = u.pn, cb = wc * 32 + 8 * fq;
        const bool latent = u.pm < T / 256;
        float one_ = 1.f; asm volatile("" : "+v"(one_));
#pragma unroll
        for (int bj = 0; bj < 2; ++bj) {
            const int col = pn * 256 + bj * 128 + cb;
            const bool gate = (pn >= 2 && pn <= 5);
            const bool rope = latent && (pn == 10 || pn == 11 || (pn == 12 && bj == 0));
            const bool isq = (pn == 10 || pn == 11);
            f32x4 l0 = (f32x4){0.f, 0.f, 0.f, 0.f}, l1 = l0;
            if (gate) { const float* lb = LB + (col - C_FF); l0 = *(const GAS f32x4*)lb; l1 = *(const GAS f32x4*)(lb + 4); }
#pragma unroll
            for (int ai = 0; ai < 2; ++ai)
#pragma unroll
                for (int m = 0; m < 4; ++m) {
                    const int row = row0 + ai * 128 + m * 16;
                    f32x4 v0 = acc[ai][bj][m][0], v1 = acc[ai][bj][m][1];
                    if (gate) {
#pragma unroll
                        for (int j = 0; j < 4; ++j) { const float s0 = fast_rcp(1.f + fast_exp(-v0[j])), s1 = fast_rcp(1.f + fast_exp(-v1[j]));
                            v0[j] = __log2f(l0[j] + (1.f - l0[j]) * s0); v1[j] = __log2f(l1[j] + (1.f - l1[j]) * s1); }
                    } else if (rope) {
                        const int n = row & (SEQ - 1), pos = (wc & 1) ? (n & 63) : (n >> 6);
                        const f32x4* cs = (const f32x4*)(RT + pos * 16 + 8 * (fq & 1));
                        const f32x4 c0 = cs[0], c1 = cs[1], c2 = cs[2], c3 = cs[3];
                        const float sg = (fq & 2) ? 1.f : -1.f;
                        f32x4 o0, o1;
#pragma unroll
                        for (int j = 0; j < 4; ++j) { o0[j] = __shfl_xor(v0[j], 32); o1[j] = __shfl_xor(v1[j], 32); }
                        v0[0] = v0[0] * c0[0] + sg * o0[0] * c0[1]; v0[1] = v0[1] * c0[2] + sg * o0[1] * c0[3];
                        v0[2] = v0[2] * c1[0] + sg * o0[2] * c1[1]; v0[3] = v0[3] * c1[2] + sg * o0[3] * c1[3];
                        v1[0] = v1[0] * c2[0] + sg * o1[0] * c2[1]; v1[1] = v1[1] * c2[2] + sg * o1[1] * c2[3];
                        v1[2] = v1[2] * c3[0] + sg * o1[2] * c3[1]; v1[3] = v1[3] * c3[2] + sg * o1[3] * c3[3];
                    }
                    if (isq) { v0 = v0 * QSCALE; v1 = v1 * QSCALE; }
                    else if (!gate && !rope) { v0 = v0 * one_; v1 = v1 * one_; }
                    u32x4 w; w.x = cvt_pk_bf16(v0[0], v0[1]); w.y = cvt_pk_bf16(v0[2], v0[3]); w.z = cvt_pk_bf16(v1[0], v1[1]); w.w = cvt_pk_bf16(v1[2], v1[3]);
                    *(GAS u32x4*)((unsigned char*)Z + ((unsigned)row * (unsigned)INC + (unsigned)col) * 2u) = w;
                }
        }
    }
};
struct EpiR1 {
#ifdef EXP_DOUBLE_EPI
    static constexpr bool DOUBLE = (EXP_DOUBLE_EPI == 2);
#endif
    const float* x; const float* mod; bf16* R1;
    __device__ __forceinline__ void operator()(const acc_t& acc, const pg8::Unit& u, int wr, int wc, int fr, int fq) const {
        const int row0 = u.pm * 256 + wr * 64 + fr, b = (u.pm * 256) >> 12;
#pragma unroll
        for (int bj = 0; bj < 2; ++bj) {
            const int col = u.pn * 256 + bj * 128 + wc * 32 + 8 * fq;
            const f32x4 g0 = *(const GAS f32x4*)(mod + b * 6144 + 2048 + col), g1 = *(const GAS f32x4*)(mod + b * 6144 + 2048 + col + 4);
#pragma unroll
            for (int ai = 0; ai < 2; ++ai)
#pragma unroll
                for (int m = 0; m < 4; ++m) { const unsigned off = (unsigned)(row0 + ai * 128 + m * 16) * DM + (unsigned)col;
                    const f32x4 x0 = *(const GAS f32x4*)((const unsigned char*)x + off * 4u), x1 = *(const GAS f32x4*)((const unsigned char*)x + (off * 4u + 16u));
                    const f32x4 r0 = x0 * ALPHA + g0 * acc[ai][bj][m][0], r1 = x1 * ALPHA + g1 * acc[ai][bj][m][1];
                    u32x4 w; w.x = cvt_pk_bf16(r0[0], r0[1]); w.y = cvt_pk_bf16(r0[2], r0[3]); w.z = cvt_pk_bf16(r1[0], r1[1]); w.w = cvt_pk_bf16(r1[2], r1[3]);
                    *(GAS u32x4*)((unsigned char*)R1 + off * 2u) = w; }
        }
    }
};
__device__ __forceinline__ s16x4 ds_tr(const LAS unsigned char* p) { return __builtin_bit_cast(s16x4, __builtin_amdgcn_ds_read_tr16_b64_v4i16((LAS s16x4*)p)); }
#define MFMA16(a, b, c) __builtin_amdgcn_mfma_f32_16x16x32_bf16((a), (b), (c), 0, 0, 0)
constexpr int AP = 144;
__device__ __forceinline__ void attn_phase(LAS unsigned char* lds, int vcu, int G) {
    const bf16* Z = (const bf16*)(WS() + WS_Z); bf16* Y = (bf16*)(WS() + WS_Y); const float* sink = IN(10);
    int tid_ = threadIdx.x; asm volatile("" : "+v"(tid_)); const int tid = tid_, wid = __builtin_amdgcn_readfirstlane(tid >> 6), lane = tid & 63, fr = lane & 15, fq = lane >> 4;
    LAS unsigned char* KV = lds;
    const int lkey = tid >> 3, lch = tid & 7;
    for (int u = vcu; u < NB * 32 * 2; u += G) {
        const int b = u >> 6, band = (((u >> 1) & 31) + 8 * (u >> 8)) & 31, kvh = u & 1, qh = kvh * 4 + (wid >> 1), i0 = (wid & 1) * 64;
        const int twlo = (band == 0) ? 2 : 0, twhi = (band == 31) ? 3 : 5, ntile = 4 + (twhi - twlo + 1);
        LAS unsigned char* Qs = lds + 4 * 64 * AP + wid * (64 * AP);
#pragma unroll
        for (int i = 0; i < 8; ++i) { const int idx = lane + 64 * i, row = idx >> 3, ch = idx & 7;
            *(LAS u32x4*)(Qs + row * AP + ch * 16) = *(const GAS u32x4*)(Z + (size_t)(b * SEQ + band * 128 + i0 + row) * INC + C_AQ + qh * 64 + ch * 8); }
        float mrun[4]; f32x4 lacc[4], o[4][4];
        const float m0 = sink[qh] * LOG2E;
#pragma unroll
        for (int qt = 0; qt < 4; ++qt) { mrun[qt] = m0; lacc[qt] = (f32x4){1.f, 1.f, 1.f, 1.f};
#pragma unroll
            for (int dt = 0; dt < 4; ++dt) o[dt][qt] = (f32x4){0.f, 0.f, 0.f, 0.f}; }
        u32x4 kreg, vreg, kreg2, vreg2;
#define ATT_ROW(nn) (((nn) < 4) ? (size_t)(T + b * CTXL + (nn) * 64 + lkey) : (size_t)(b * SEQ + band * 128 - 128 + (twlo + (nn) - 4) * 64 + lkey))
        { const size_t row = ATT_ROW(0); kreg = *(const GAS u32x4*)(Z + row * INC + C_AK + kvh * 64 + lch * 8); vreg = *(const GAS u32x4*)(Z + row * INC + C_AV + kvh * 64 + lch * 8); }
        { const size_t row = ATT_ROW(1); kreg2 = *(const GAS u32x4*)(Z + row * INC + C_AK + kvh * 64 + lch * 8); vreg2 = *(const GAS u32x4*)(Z + row * INC + C_AV + kvh * 64 + lch * 8); }
        WG_BAR();
        *(LAS u32x4*)(KV + lkey * AP + lch * 16) = kreg; *(LAS u32x4*)(KV + 64 * AP + lkey * AP + lch * 16) = vreg;
        kreg = kreg2; vreg = vreg2;
        { const size_t row = ATT_ROW(2); kreg2 = *(const GAS u32x4*)(Z + row * INC + C_AK + kvh * 64 + lch * 8); vreg2 = *(const GAS u32x4*)(Z + row * INC + C_AV + kvh * 64 + lch * 8); }
        for (int n = 0; n < ntile; ++n) {
            WG_BAR();
            int z_ = 0; asm volatile("" : "+v"(z_));
            LAS unsigned char* Ks = KV + z_ + (n & 1) * (128 * AP); LAS unsigned char* Vs = Ks + 64 * AP;
            if (n + 1 < ntile) { LAS unsigned char* Kn = KV + ((n + 1) & 1) * (128 * AP);
                *(LAS u32x4*)(Kn + lkey * AP + lch * 16) = kreg; *(LAS u32x4*)(Kn + 64 * AP + lkey * AP + lch * 16) = vreg; kreg = kreg2; vreg = vreg2;
                if (n + 3 < ntile) { const size_t row = ATT_ROW(n + 3); kreg2 = *(const GAS u32x4*)(Z + row * INC + C_AK + kvh * 64 + lch * 8); vreg2 = *(const GAS u32x4*)(Z + row * INC + C_AV + kvh * 64 + lch * 8); } }
            const int tw = (n < 4) ? -1 : (twlo + n - 4);
            bool need = true, mask = false;
            if (tw >= 0) { need = (tw * 64 + 63 >= i0) && (tw * 64 <= i0 + 63 + 256); mask = !((tw * 64 >= i0 + 63) && (tw * 64 + 63 <= i0 + 256)); }
            if (!need) continue;
            bf16x8 kf[4][2];
#pragma unroll
            for (int kt = 0; kt < 4; ++kt)
#pragma unroll
                for (int ks = 0; ks < 2; ++ks) kf[kt][ks] = *(const LAS bf16x8*)(Ks + (kt * 16 + fr) * AP + ks * 64 + fq * 16);
#define ATT_S_ISSUE(q, dst) do { bf16x8 qf_[2]; \
                _Pragma("unroll") for (int ks = 0; ks < 2; ++ks) qf_[ks] = *(const LAS bf16x8*)(Qs + z_ + ((q) * 16 + fr) * AP + ks * 64 + fq * 16); \
                const float nm_ = -mrun[(q)];                         \
                _Pragma("unroll") for (int kt = 0; kt < 4; ++kt) { dst[kt] = MFMA16(kf[kt][0], qf_[0], ((f32x4){nm_, nm_, nm_, nm_})); dst[kt] = MFMA16(kf[kt][1], qf_[1], dst[kt]); } } while (0)
#define ATT_MAXV(sv, tmv) do { tmv = __builtin_fmaxf(__builtin_fmaxf(sv[0][0], sv[0][1]), sv[0][2]); \
                tmv = __builtin_fmaxf(__builtin_fmaxf(tmv, sv[0][3]), sv[1][0]); tmv = __builtin_fmaxf(__builtin_fmaxf(tmv, sv[1][1]), sv[1][2]); tmv = __builtin_fmaxf(__builtin_fmaxf(tmv, sv[1][3]), sv[2][0]); \
                tmv = __builtin_fmaxf(__builtin_fmaxf(tmv, sv[2][1]), sv[2][2]); tmv = __builtin_fmaxf(__builtin_fmaxf(tmv, sv[2][3]), sv[3][0]); tmv = __builtin_fmaxf(__builtin_fmaxf(tmv, sv[3][1]), sv[3][2]); tmv = __builtin_fmaxf(tmv, sv[3][3]); } while (0)
#define ATT_MAXX(tmv) do { auto r16 = __builtin_amdgcn_permlane16_swap(__float_as_uint(tmv), __float_as_uint(tmv), false, false); tmv = fmaxf(__uint_as_float(r16[0]), __uint_as_float(r16[1])); \
                  auto r32 = __builtin_amdgcn_permlane32_swap(__float_as_uint(tmv), __float_as_uint(tmv), false, false); tmv = fmaxf(__uint_as_float(r32[0]), __uint_as_float(r32[1])); } while (0)
#define ATT_MASK(sv, q) do { const int i = i0 + (q) * 16 + fr; \
                _Pragma("unroll") for (int kt = 0; kt < 4; ++kt) _Pragma("unroll") for (int r = 0; r < 4; ++r) { const int j = tw * 64 + kt * 16 + fq * 4 + r; if (!(j >= i && j <= i + 256)) sv[kt][r] = -INFINITY; } } while (0)
#define ATT_PACK(sv, pfv) do { _Pragma("unroll") for (int kt = 0; kt < 4; ++kt) _Pragma("unroll") for (int r = 0; r < 4; ++r) sv[kt][r] = fast_exp2(sv[kt][r]); \
                _Pragma("unroll") for (int k2 = 0; k2 < 2; ++k2) { u32x4 w; w.x = cvt_pk_bf16(sv[2 * k2][0], sv[2 * k2][1]); w.y = cvt_pk_bf16(sv[2 * k2][2], sv[2 * k2][3]); w.z = cvt_pk_bf16(sv[2 * k2 + 1][0], sv[2 * k2 + 1][1]); w.w = cvt_pk_bf16(sv[2 * k2 + 1][2], sv[2 * k2 + 1][3]); pfv[k2] = __builtin_bit_cast(bf16x8, w); } } while (0)
#pragma unroll
            for (int qp = 0; qp < 2; ++qp) {
                const int qa = 2 * qp, qb = 2 * qp + 1;
                f32x4 sa[4], sc4[4];
                ATT_S_ISSUE(qa, sa); ATT_S_ISSUE(qb, sc4);
                if (mask) { ATT_MASK(sa, qa); ATT_MASK(sc4, qb); }
                float tma, tmb; ATT_MAXV(sa, tma); ATT_MAXV(sc4, tmb);
                asm volatile("" : "+v"(tma), "+v"(tmb));
                ATT_MAXX(tma); ATT_MAXX(tmb);
                if (__any(tma > 0.f || tmb > 0.f)) {
                    const float dla = fmaxf(tma, 0.f), sca = fast_exp2(-dla), dlb = fmaxf(tmb, 0.f), scb = fast_exp2(-dlb); mrun[qa] += dla; mrun[qb] += dlb;
#pragma unroll
                    for (int kt = 0; kt < 4; ++kt) { sa[kt] = sa[kt] - dla; sc4[kt] = sc4[kt] - dlb; }
                    lacc[qa] = lacc[qa] * sca; lacc[qb] = lacc[qb] * scb;
#pragma unroll
                    for (int dt = 0; dt < 4; ++dt) { o[dt][qa] = o[dt][qa] * sca; o[dt][qb] = o[dt][qb] * scb; }
                }
                bf16x8 pfa[2], pfb[2];
                ATT_PACK(sa, pfa); ATT_PACK(sc4, pfb);
                { const bf16x8 ones = (bf16x8){0x3f80, 0x3f80, 0x3f80, 0x3f80, 0x3f80, 0x3f80, 0x3f80, 0x3f80};
                  lacc[qa] = MFMA16(ones, pfa[0], lacc[qa]); lacc[qb] = MFMA16(ones, pfb[0], lacc[qb]); lacc[qa] = MFMA16(ones, pfa[1], lacc[qa]); lacc[qb] = MFMA16(ones, pfb[1], lacc[qb]); }
#pragma unroll
                for (int dt = 0; dt < 4; ++dt) { bf16x8 vf[2];
#pragma unroll
                    for (int k2 = 0; k2 < 2; ++k2) { const LAS unsigned char* vp = Vs + (k2 * 32 + fq * 4 + (fr >> 2)) * AP + dt * 32 + (fr & 3) * 8;
                        const s16x4 lo = ds_tr(vp), hi = ds_tr(vp + 16 * AP); vf[k2] = (bf16x8){lo[0], lo[1], lo[2], lo[3], hi[0], hi[1], hi[2], hi[3]}; }
                    f32x4 a = o[dt][qa], c = o[dt][qb]; a = MFMA16(vf[0], pfa[0], a); c = MFMA16(vf[0], pfb[0], c); a = MFMA16(vf[1], pfa[1], a); c = MFMA16(vf[1], pfb[1], c); o[dt][qa] = a; o[dt][qb] = c; }
            }
        }
#undef ATT_MAXV
#undef ATT_MAXX
#undef ATT_MASK
#undef ATT_PACK
        asm volatile("" : "+v"(o[3][3]), "+v"(lacc[3]));
#pragma unroll
        for (int qt = 0; qt < 4; ++qt) { const float rl = 1.f / lacc[qt][0];
            bf16* yp = Y + (size_t)(b * SEQ + band * 128 + i0 + qt * 16 + fr) * DM + 512 + qh * 64;
#pragma unroll
            for (int dp = 0; dp < 2; ++dp) {
                const f32x4 a = o[2 * dp][qt] * rl, c = o[2 * dp + 1][qt] * rl;
                const unsigned a0 = cvt_pk_bf16(a[0], a[1]), a1 = cvt_pk_bf16(a[2], a[3]), c0 = cvt_pk_bf16(c[0], c[1]), c1 = cvt_pk_bf16(c[2], c[3]);
                const auto s0 = __builtin_amdgcn_permlane16_swap(a0, c0, false, false), s1 = __builtin_amdgcn_permlane16_swap(a1, c1, false, false);
                const u32x4 w = (u32x4){s0[0], s1[0], s0[1], s1[1]};
                *(GAS u32x4*)(yp + (2 * dp + (fq & 1)) * 16 + 4 * (fq & 2)) = w; } }
    }
#undef ATT_ROW
#undef ATT_S_ISSUE
    __syncthreads();
}
constexpr int HP = 272;
constexpr int L_KB = 0;
constexpr int L_KD = 64 * HP;
constexpr int L_QH = 128 * HP;
constexpr int L_QV = 192 * HP;
constexpr int L_V = 240 * HP;
constexpr int L_ST = L_V + 64 * HP;
constexpr int L_ATT = L_ST + 128 * HP;
constexpr int L_TOT = L_ATT + 8 * 16 * 144;
constexpr int L_FQ = L_TOT + 2048;
constexpr int L_FE = L_FQ + 2048;
constexpr int L_DEC = L_FE + 2048;
constexpr int L_SS = L_DEC + 512;
constexpr int L_KH0 = L_KB;
static_assert(L_SS + 512 <= MISC_TOP, "HGRN LDS map");

struct HgrnChain { const bf16* Z; int rowbase; int h; int dir; };

template <bool WITH_OUT>
struct HgrnStep {
    unsigned greg[16], qreg[16]; u32x4 vreg[2];
    __device__ __forceinline__ void prefetch(const HgrnChain& c, int c0, int wid, int lane, int tid) {
        const int n = wid & 3, role = wid >> 2;
        const int gcol = (c.dir ? C_FB : C_FF) + c.h * 128 + 2 * lane, qcol = C_Q + c.h * 128 + 2 * lane;
#pragma unroll
        for (int t = 0; t < 16; ++t) { const int p = 16 * n + t, tk = c.dir ? (c0 + 63 - p) : (c0 + p); const bf16* rp = c.Z + (size_t)(c.rowbase + tk) * INC;
            greg[t] = *(const GAS unsigned*)(rp + gcol); if (WITH_OUT && role == 1) qreg[t] = *(const GAS unsigned*)(rp + qcol); }
#pragma unroll
        for (int i = 0; i < 2; ++i) { const int idx = tid + 512 * i, p = idx >> 4, ch = idx & 15, tk = c.dir ? (c0 + 63 - p) : (c0 + p);
            vreg[i] = *(const GAS u32x4*)(c.Z + (size_t)(c.rowbase + tk) * INC + C_I + c.h * 128 + ch * 8); }
    }
};

struct HgrnEpf { u32x4 of[2], zg[2]; const bf16* ofp; const bf16* zgp; bool on;
    __device__ __forceinline__ void issue() { if (on) { of[0] = *(const GAS u32x4*)ofp; of[1] = *(const GAS u32x4*)(ofp + 8); zg[0] = *(const GAS u32x4*)zgp; zg[1] = *(const GAS u32x4*)(zgp + 8); } } };
template <bool WITH_OUT>
__device__ __forceinline__ void hgrn_chunk(LAS unsigned char* lds, HgrnStep<WITH_OUT>& pf, f32x4 (&st)[8], f32x4 (&oacc)[4], float (&segsum)[2],
                                           const HgrnChain& c, int next_c0, bool has_next, HgrnEpf& epf, int wid, int lane, int tid) {
    const int n = wid & 3, role = wid >> 2, fr = lane & 15, fq = lane >> 4, d0 = 2 * lane;
    LAS float* TOT = (LAS float*)(lds + L_TOT); LAS float* FQ = (LAS float*)(lds + L_FQ); LAS float* DEC = (LAS float*)(lds + L_DEC);
    float one_ = 1.f; asm volatile("" : "+v"(one_));


    f32x2 gl[16], cs[16];
    { f32x2 a = (f32x2){0.f, 0.f};
#pragma unroll
      for (int t = 0; t < 16; ++t) { gl[t] = (f32x2){bf_lo(pf.greg[t]), bf_hi(pf.greg[t])}; a += (f32x2){fmaxf(gl[t].x, LOGF_MIN2), fmaxf(gl[t].y, LOGF_MIN2)}; cs[t] = a; } }
    if (role == 0) *(LAS f32x2*)(TOT + n * 128 + d0) = cs[15];
#pragma unroll
    for (int i = 0; i < 2; ++i) { const int idx = tid + 512 * i, p = idx >> 4, ch = idx & 15; *(LAS u32x4*)(lds + L_V + p * HP + ch * 16) = pf.vreg[i]; }
    WG_BAR();
    { int z_ = 0; asm volatile("" : "+v"(z_)); lds = lds + z_; }
    f32x2 R[5];
    { R[0] = (f32x2){0.f, 0.f};
#pragma unroll
      for (int q = 0; q < 4; ++q) R[q + 1] = R[q] + *(const LAS f32x2*)(TOT + q * 128 + d0); }
#define EXP2V(v) ((f32x2){fast_exp2((v).x), fast_exp2((v).y)})
    if (role == 0) {
        const f32x2 tot = cs[15];
        const f32x2 eD = EXP2V(-tot);
        f32x2 E = (f32x2){1.f, 1.f};
#pragma unroll
        for (int t = 15; t >= 0; --t) {
            if ((t & 3) == 3) __builtin_amdgcn_sched_barrier(0);
            const f32x2 f = EXP2V(gl[t]);
            const f32x2 ke = (1.f - f) * E;
            E = E * (f32x2){fmaxf(f.x, 0.01831563888873418f), fmaxf(f.y, 0.01831563888873418f)};
            const int rowoff = (16 * n + t) * HP + d0 * 2;
            *(LAS unsigned*)(lds + L_KB + rowoff) = cvt_pk_bf16(ke.x, ke.y);
            { const f32x2 v = ke * eD; *(LAS unsigned*)(lds + L_KD + rowoff) = cvt_pk_bf16(v.x, v.y); }
        }
        *(LAS f32x2*)(FQ + n * 128 + d0) = EXP2V(R[n]);
        *(LAS f32x2*)((LAS float*)(lds + L_FE) + n * 128 + d0) = EXP2V(R[4] - R[n + 1]);
        if (n == 3) { *(LAS f32x2*)(DEC + d0) = EXP2V(R[4]); segsum[0] += R[4].x; segsum[1] += R[4].y; }
    } else {
        const f32x2 f20 = EXP2V(R[n] - R[1]), f31 = EXP2V(R[3] - R[2]);
#pragma unroll
        for (int t = 0; t < 16; ++t) { if ((t & 3) == 0) __builtin_amdgcn_sched_barrier(0);
            const f32x2 v = (f32x2){bf_lo(pf.qreg[t]), bf_hi(pf.qreg[t])} * EXP2V(cs[t]);
            *(LAS unsigned*)(lds + L_QH + (16 * n + t) * HP + d0 * 2) = cvt_pk_bf16(v.x, v.y);
            if (n >= 2) { const f32x2 w = v * f20; *(LAS unsigned*)(lds + L_QV + ((n - 2) * 16 + t) * HP + d0 * 2) = cvt_pk_bf16(w.x, w.y); }
            if (n == 3) { const f32x2 w = v * f31; *(LAS unsigned*)(lds + L_QV + (32 + t) * HP + d0 * 2) = cvt_pk_bf16(w.x, w.y); } }
    }
    WG_BAR();
    { int z_ = 0; asm volatile("" : "+v"(z_)); lds = lds + z_; }
    epf.issue();
    if (WITH_OUT) {
        const int eh = wid >> 2;
        bf16x8 aq[4];
#pragma unroll
        for (int ks = 0; ks < 4; ++ks) aq[ks] = *(const LAS bf16x8*)(lds + L_QH + (16 * n + fr) * HP + ks * 64 + fq * 16);
        unsigned pw[4][2];
#pragma unroll
        for (int m = 0; m < 4; ++m) {
            if (m <= n) { f32x4 a = (f32x4){0.f, 0.f, 0.f, 0.f};
                const int kb = ((m == n) ? L_KD : L_KB) + (16 * m + fr) * HP + fq * 16;
                const int qv = L_QV + (((n == 2) ? 0 : (16 + 16 * m)) + fr) * HP + fq * 16;
                if (m + 2 <= n) {
#pragma unroll
                    for (int ks = 0; ks < 4; ++ks) { const bf16x8 bk = *(const LAS bf16x8*)(lds + kb + ks * 64), av = *(const LAS bf16x8*)(lds + qv + ks * 64); a = MFMA16(bk, av, a); }
                } else {
#pragma unroll
                    for (int ks = 0; ks < 4; ++ks) { const bf16x8 bk = *(const LAS bf16x8*)(lds + kb + ks * 64); a = MFMA16(bk, aq[ks], a); }
                }
                float v[4];
#pragma unroll
                for (int r = 0; r < 4; ++r) { v[r] = a[r] * one_; if (m == n && fq * 4 + r > fr) v[r] = 0.f; }
                pw[m][0] = cvt_pk_bf16(v[0], v[1]); pw[m][1] = cvt_pk_bf16(v[2], v[3]); }
            else { pw[m][0] = 0u; pw[m][1] = 0u; }
        }
        bf16x8 qt[4];
#pragma unroll
        for (int ks = 0; ks < 4; ++ks) { const f32x4 f0 = *(const LAS f32x4*)(FQ + n * 128 + ks * 32 + fq * 8), f1 = *(const LAS f32x4*)(FQ + n * 128 + ks * 32 + fq * 8 + 4);
            const u32x4 w = __builtin_bit_cast(u32x4, aq[ks]); u32x4 o;
            { const f32x2 a = (f32x2){bf_lo(w.x), bf_hi(w.x)} * (f32x2){f0[0], f0[1]}, b = (f32x2){bf_lo(w.y), bf_hi(w.y)} * (f32x2){f0[2], f0[3]}; o.x = cvt_pk_bf16(a.x, a.y); o.y = cvt_pk_bf16(b.x, b.y); }
            { const f32x2 a = (f32x2){bf_lo(w.z), bf_hi(w.z)} * (f32x2){f1[0], f1[1]}, b = (f32x2){bf_lo(w.w), bf_hi(w.w)} * (f32x2){f1[2], f1[3]}; o.z = cvt_pk_bf16(a.x, a.y); o.w = cvt_pk_bf16(b.x, b.y); }
            qt[ks] = __builtin_bit_cast(bf16x8, o); }
        bf16x8 pa[2];
        pa[0] = __builtin_bit_cast(bf16x8, ((u32x4){pw[0][0], pw[0][1], pw[1][0], pw[1][1]})); pa[1] = __builtin_bit_cast(bf16x8, ((u32x4){pw[2][0], pw[2][1], pw[3][0], pw[3][1]}));
#pragma unroll
        for (int et = 0; et < 4; ++et) { const int eb = 4 * eh + et; f32x4 a = (f32x4){0.f, 0.f, 0.f, 0.f};
            bf16x8 bs[4], bv[2];
#pragma unroll
            for (int ks = 0; ks < 4; ++ks) bs[ks] = *(const LAS bf16x8*)(lds + L_ST + (eb * 16 + fr) * HP + ks * 64 + fq * 16);
#pragma unroll
            for (int k2 = 0; k2 < 2; ++k2) { const LAS unsigned char* vp = lds + L_V + (32 * k2 + 4 * fq + (fr >> 2)) * HP + eb * 32 + (fr & 3) * 8;
                const s16x4 lo = ds_tr(vp), hi = ds_tr(vp + 16 * HP); bv[k2] = (bf16x8){lo[0], lo[1], lo[2], lo[3], hi[0], hi[1], hi[2], hi[3]}; }
#pragma unroll
            for (int ks = 0; ks < 4; ++ks) a = MFMA16(qt[ks], bs[ks], a);
            a = MFMA16(pa[0], bv[0], a);
            if (n >= 2) a = MFMA16(pa[1], bv[1], a);
            oacc[et] = a; }
    }
    { int z_ = 0; asm volatile("" : "+v"(z_)); lds = lds + z_; }
    {
        const f32x4 dec = *(const LAS f32x4*)(DEC + 16 * wid + 4 * fq);
        bf16x8 ak[2];
#pragma unroll
        for (int k2 = 0; k2 < 2; ++k2) { const LAS unsigned char* kp = lds + L_KB + (32 * k2 + 8 * fq + (fr >> 2)) * HP + wid * 32 + (fr & 3) * 8;
            const s16x4 lo = ds_tr(kp), hi = ds_tr(kp + 4 * HP);
            const float fe = ((const LAS float*)(lds + L_FE))[(2 * k2 + (fq >> 1)) * 128 + 16 * wid + fr];
            const u32x2 l2 = __builtin_bit_cast(u32x2, lo), h2 = __builtin_bit_cast(u32x2, hi); u32x4 o;
            o.x = cvt_pk_bf16(bf_lo(l2.x) * fe, bf_hi(l2.x) * fe); o.y = cvt_pk_bf16(bf_lo(l2.y) * fe, bf_hi(l2.y) * fe);
            o.z = cvt_pk_bf16(bf_lo(h2.x) * fe, bf_hi(h2.x) * fe); o.w = cvt_pk_bf16(bf_lo(h2.y) * fe, bf_hi(h2.y) * fe);
            ak[k2] = __builtin_bit_cast(bf16x8, o); }
#pragma unroll
        for (int eb = 0; eb < 8; ++eb) { f32x4 a = st[eb] * dec;
#pragma unroll
            for (int k2 = 0; k2 < 2; ++k2) { const LAS unsigned char* vp = lds + L_V + (32 * k2 + 8 * fq + (fr >> 2)) * HP + eb * 32 + (fr & 3) * 8;
                const s16x4 lo = ds_tr(vp), hi = ds_tr(vp + 4 * HP); const bf16x8 bv = (bf16x8){lo[0], lo[1], lo[2], lo[3], hi[0], hi[1], hi[2], hi[3]}; a = MFMA16(ak[k2], bv, a); }
            st[eb] = a; }
    }
    if (has_next) pf.prefetch(c, next_c0, wid, lane, tid);
    WG_BAR();
    if (WITH_OUT) {
#pragma unroll
        for (int eb = 0; eb < 8; ++eb) { const f32x4 t = st[eb] * one_; u32x2 w; w.x = cvt_pk_bf16(t[0], t[1]); w.y = cvt_pk_bf16(t[2], t[3]); *(LAS u32x2*)(lds + L_ST + (eb * 16 + fr) * HP + (16 * wid + 4 * fq) * 2) = w; }
    }
}

__device__ __forceinline__ void hgrn_state_init(f32x4 (&st)[8], const float* SEG, const float* SEGD, int chain, int slot_first, int slot_step, int nslots_latent, int wid, int lane) {
    const int fr = lane & 15, fq = lane >> 4;
#pragma unroll
    for (int eb = 0; eb < 8; ++eb) st[eb] = (f32x4){0.f, 0.f, 0.f, 0.f};
    f32x4 Pd = (f32x4){1.f, 1.f, 1.f, 1.f};
    int slot = slot_first;
    for (int it = 0; it <= nslots_latent; ++it) {
        const int sl = (it < nslots_latent) ? slot : 0;
        const float* X = SEG + ((size_t)chain * 9 + sl) * 16384 + (size_t)(wid * 64 + lane) * 32;
#pragma unroll
        for (int eb = 0; eb < 8; ++eb) st[eb] += Pd * *(const GAS f32x4*)(X + 4 * eb);
        const f32x4 dd = *(const GAS f32x4*)(SEGD + ((size_t)chain * 9 + sl) * 128 + 16 * wid + 4 * fq);
        Pd = Pd * dd;
        const bool live = (Pd[0] != 0.f) || (Pd[1] != 0.f) || (Pd[2] != 0.f) || (Pd[3] != 0.f);
        if (!__any(live)) break;
        slot += slot_step;
    }
}

constexpr int PA_KF = 0, PA_KB = 128 * HP, PA_V = 256 * HP, PA_TF = 384 * HP, PA_TB = PA_TF + 4096, PA_DEC = PA_TB + 4096;
struct PaRows { unsigned gf[16], gb[16]; };
__device__ __forceinline__ void pa_unit(int u, int& b, int& h, int& slot, int& nst, int& tok0, int& rowbase) {
    if (u < 512) { b = u >> 5; h = (u >> 3) & 3; slot = 1 + (u & 7); nst = 4; tok0 = (u & 7) * 512; rowbase = b * SEQ; }
    else { const int v = u - 512; b = v >> 2; h = v & 3; slot = 0; nst = 2; tok0 = 0; rowbase = T + b * CTXL; }
}
__device__ __forceinline__ void pa_load(PaRows& r, const bf16* Z, int rowbase, int h, int c0, int wid, int lane) {
    const unsigned char* base = (const unsigned char*)(Z + (size_t)(rowbase + c0) * INC + h * 128);
    unsigned go = (unsigned)(16 * wid * INC + 2 * lane) * 2u;
    asm volatile("" : "+v"(go));
#pragma unroll
    for (int t = 0; t < 16; ++t) { r.gf[t] = *(const GAS unsigned*)(base + (go + (unsigned)(t * INC + C_FF) * 2u)); r.gb[t] = *(const GAS unsigned*)(base + (go + (unsigned)(t * INC + C_FB) * 2u)); }
}
__device__ __forceinline__ void pa_load_v(u32x4 (&vr)[4], const bf16* Z, int rowbase, int h, int c0, int tid) {
    const unsigned char* base = (const unsigned char*)(Z + (size_t)(rowbase + c0) * INC + h * 128);
    unsigned vo = (unsigned)((tid >> 4) * INC + (tid & 15) * 8 + C_I) * 2u;
    asm volatile("" : "+v"(vo));
#pragma unroll
    for (int i = 0; i < 4; ++i) vr[i] = *(const GAS u32x4*)(base + (vo + (unsigned)(32 * i * INC) * 2u));
}
__device__ __forceinline__ void pa_step(LAS unsigned char* lds, const PaRows& r, u32x4 (&vr)[4], f32x4 (&stf)[8], f32x4 (&stb)[8], f32x2& segf, f32x2& lowb, int wid, int lane, int tid,
                                        const bf16* Z, bool nv, int nrowbase, int nh, int nc0) {
    const int fr = lane & 15, fq = lane >> 4, d0 = 2 * lane;
    LAS float* TF = (LAS float*)(lds + PA_TF); LAS float* TB = (LAS float*)(lds + PA_TB); LAS float* DEC = (LAS float*)(lds + PA_DEC);
    f32x2 totf = (f32x2){0.f, 0.f}, totb = totf;
#pragma unroll
    for (int t = 0; t < 16; ++t) { totf += (f32x2){fmaxf(bf_lo(r.gf[t]), LOGF_MIN2), fmaxf(bf_hi(r.gf[t]), LOGF_MIN2)}; totb += (f32x2){fmaxf(bf_lo(r.gb[t]), LOGF_MIN2), fmaxf(bf_hi(r.gb[t]), LOGF_MIN2)}; }
    *(LAS f32x2*)(TF + wid * 128 + d0) = totf; *(LAS f32x2*)(TB + wid * 128 + d0) = totb;
#pragma unroll
    for (int i = 0; i < 4; ++i) { const int idx = tid + 512 * i, p = idx >> 4, ch = idx & 15; *(LAS u32x4*)(lds + PA_V + p * HP + ch * 16) = vr[i]; }
    if (nv) pa_load_v(vr, Z, nrowbase, nh, nc0, tid);
    WG_BAR();
    { int z_ = 0; asm volatile("" : "+v"(z_)); lds = lds + z_; }
    f32x2 allf = (f32x2){0.f, 0.f}, aftf = allf, allb = allf, befb = allf;
#pragma unroll
    for (int q = 0; q < 8; ++q) { const f32x2 a = *(const LAS f32x2*)(TF + q * 128 + d0), c = *(const LAS f32x2*)(TB + q * 128 + d0); allf += a; allb += c; if (q > wid) aftf += a; if (q < wid) befb += c; }
    const float FMIN = 0.01831563888873418f;
    { f32x2 E = EXP2V(aftf);
#pragma unroll
      for (int t = 15; t >= 0; --t) { unsigned w = r.gf[t]; asm volatile("" : "+v"(w)); const f32x2 f = EXP2V(((f32x2){bf_lo(w), bf_hi(w)}));
          const f32x2 v = (1.f - f) * E; *(LAS unsigned*)(lds + PA_KF + (16 * wid + t) * HP + d0 * 2) = cvt_pk_bf16(v.x, v.y);
          E = E * (f32x2){fmaxf(f.x, FMIN), fmaxf(f.y, FMIN)}; } }
    { f32x2 E = EXP2V(lowb + befb);
#pragma unroll
      for (int t = 0; t < 16; ++t) { unsigned w = r.gb[t]; asm volatile("" : "+v"(w)); const f32x2 f = EXP2V(((f32x2){bf_lo(w), bf_hi(w)}));
          const f32x2 v = (1.f - f) * E; *(LAS unsigned*)(lds + PA_KB + (16 * wid + t) * HP + d0 * 2) = cvt_pk_bf16(v.x, v.y);
          E = E * (f32x2){fmaxf(f.x, FMIN), fmaxf(f.y, FMIN)}; } }
    if (wid == 7) *(LAS f32x2*)(DEC + d0) = EXP2V(allf);
    segf += allf; lowb += allb;
    WG_BAR();
    { int z_ = 0; asm volatile("" : "+v"(z_)); lds = lds + z_; }
    { const f32x4 dec = *(const LAS f32x4*)(DEC + 16 * wid + 4 * fq);
      bf16x8 akf[4], akb[4];
#pragma unroll
      for (int k2 = 0; k2 < 4; ++k2) { const int off = (32 * k2 + 8 * fq + (fr >> 2)) * HP + wid * 32 + (fr & 3) * 8;
          { const s16x4 lo = ds_tr(lds + PA_KF + off), hi = ds_tr(lds + PA_KF + off + 4 * HP); akf[k2] = (bf16x8){lo[0], lo[1], lo[2], lo[3], hi[0], hi[1], hi[2], hi[3]}; }
          { const s16x4 lo = ds_tr(lds + PA_KB + off), hi = ds_tr(lds + PA_KB + off + 4 * HP); akb[k2] = (bf16x8){lo[0], lo[1], lo[2], lo[3], hi[0], hi[1], hi[2], hi[3]}; } }
#pragma unroll
      for (int eb = 0; eb < 8; ++eb) { f32x4 a = stf[eb] * dec, c = stb[eb];
#pragma unroll
          for (int k2 = 0; k2 < 4; ++k2) { const LAS unsigned char* vp = lds + PA_V + (32 * k2 + 8 * fq + (fr >> 2)) * HP + eb * 32 + (fr & 3) * 8;
              const s16x4 lo = ds_tr(vp), hi = ds_tr(vp + 4 * HP); const bf16x8 bv = (bf16x8){lo[0], lo[1], lo[2], lo[3], hi[0], hi[1], hi[2], hi[3]}; a = MFMA16(akf[k2], bv, a); c = MFMA16(akb[k2], bv, c); }
          stf[eb] = a; stb[eb] = c; } }
    WG_BAR();
}
__device__ __forceinline__ void hgrn_pass_a(LAS unsigned char* lds, int vcu, int G) {
    const bf16* Z = (const bf16*)(WS() + WS_Z); float* SEG = (float*)(WS() + WS_SEG); float* SEGD = (float*)(WS() + WS_SEGD);
    int tid_ = threadIdx.x; asm volatile("" : "+v"(tid_)); const int tid = tid_, wid = __builtin_amdgcn_readfirstlane(tid >> 6), lane = tid & 63, d0 = 2 * lane;
    PaRows ra, rb; u32x4 vr[4];
    if (vcu < 576) { int b, h, slot, nst, tok0, rowbase; pa_unit(vcu, b, h, slot, nst, tok0, rowbase); pa_load(ra, Z, rowbase, h, tok0, wid, lane); pa_load_v(vr, Z, rowbase, h, tok0, tid); }
    for (int u = vcu; u < 576; u += G) {
        int b, h, slot, nst, tok0, rowbase; pa_unit(u, b, h, slot, nst, tok0, rowbase);
        int b2 = 0, h2 = 0, slot2, nst2, tok2 = 0, rowbase2 = 0; const bool more = u + G < 576; if (more) pa_unit(u + G, b2, h2, slot2, nst2, tok2, rowbase2);
        f32x4 stf[8], stb[8]; f32x2 segf = (f32x2){0.f, 0.f}, lowb = segf;
#pragma unroll
        for (int eb = 0; eb < 8; ++eb) { stf[eb] = (f32x4){0.f, 0.f, 0.f, 0.f}; stb[eb] = stf[eb]; }
        for (int k = 0; k < nst; k += 2) {
            const bool last = k + 2 >= nst;
            pa_load(rb, Z, rowbase, h, tok0 + (k + 1) * 128, wid, lane);
            pa_step(lds, ra, vr, stf, stb, segf, lowb, wid, lane, tid, Z, true, rowbase, h, tok0 + (k + 1) * 128);
            if (!last) pa_load(ra, Z, rowbase, h, tok0 + (k + 2) * 128, wid, lane);
            else if (more) pa_load(ra, Z, rowbase2, h2, tok2, wid, lane);
            pa_step(lds, rb, vr, stf, stb, segf, lowb, wid, lane, tid, Z, !last || more, last ? rowbase2 : rowbase, last ? h2 : h, last ? tok2 : tok0 + (k + 2) * 128);
        }
        const int chain = (b * 4 + h) * 2;
        float* Xf = SEG + ((size_t)chain * 9 + slot) * 16384 + (size_t)(wid * 64 + lane) * 32;
        float* Xb = SEG + ((size_t)(chain + 1) * 9 + slot) * 16384 + (size_t)(wid * 64 + lane) * 32;
#pragma unroll
        for (int eb = 0; eb < 8; ++eb) { *(GAS f32x4*)(Xf + 4 * eb) = stf[eb]; *(GAS f32x4*)(Xb + 4 * eb) = stb[eb]; }
        if (wid == 7) { *(GAS f32x2*)(SEGD + ((size_t)chain * 9 + slot) * 128 + d0) = (f32x2){exp2f(segf.x), exp2f(segf.y)};
                        *(GAS f32x2*)(SEGD + ((size_t)(chain + 1) * 9 + slot) * 128 + d0) = (f32x2){exp2f(lowb.x), exp2f(lowb.y)}; }
    }
    __syncthreads();
}

constexpr int OTP = 528;
__device__ __forceinline__ void hgrn_pass_c(LAS unsigned char* lds, int vcu, int G) {
    const bf16* Z = (const bf16*)(WS() + WS_Z); const float* SEG = (const float*)(WS() + WS_SEG); const float* SEGD = (const float*)(WS() + WS_SEGD);
    bf16* Y = (bf16*)(WS() + WS_Y); const float* nw = IN(9);
    int tid_ = threadIdx.x; asm volatile("" : "+v"(tid_)); const int tid = tid_, wid = __builtin_amdgcn_readfirstlane(tid >> 6), lane = tid & 63, fr = lane & 15, fq = lane >> 4, n = wid & 3, eh = wid >> 2;
    LAS float* NW = (LAS float*)(lds + L_SS);
    const int ep = tid >> 3, es = tid & 7;
    for (int u = vcu; u < 512; u += G) {
        const int b = u >> 5, h = (u >> 3) & 3, s = u & 7, tok0 = s * 512;
        bf16* OF = (bf16*)(WS() + WS_OF) + (size_t)u * 512 * 128;
        if (tid < 128) NW[tid] = nw[h * 128 + tid];
        for (int dir = 0; dir < 2; ++dir) {
            HgrnChain c{Z, b * SEQ, h, dir};
            const int chain = (b * 4 + h) * 2 + dir;
            f32x4 st[8], oacc[4]; float segsum[2] = {0.f, 0.f};
            if (dir == 0) hgrn_state_init(st, SEG, SEGD, chain, s, -1, s, wid, lane);
            else hgrn_state_init(st, SEG, SEGD, chain, s + 2, 1, 7 - s, wid, lane);
#pragma unroll
            for (int eb = 0; eb < 8; ++eb) { u32x2 w; w.x = cvt_pk_bf16(st[eb][0], st[eb][1]); w.y = cvt_pk_bf16(st[eb][2], st[eb][3]); *(LAS u32x2*)(lds + L_ST + (eb * 16 + fr) * HP + (16 * wid + 4 * fq) * 2) = w; }
            HgrnStep<true> pf; HgrnEpf epf; epf.on = (dir == 1);
            pf.prefetch(c, dir ? (tok0 + 7 * 64) : tok0, wid, lane, tid);
            for (int k = 0; k < 8; ++k) { const int kn = k + 1, c0 = tok0 + (dir ? (7 - k) : k) * 64, nc0 = tok0 + (dir ? (7 - kn) : kn) * 64;
                const int tl = dir ? (c0 - tok0 + 63 - ep) : (c0 - tok0 + ep);
                epf.ofp = OF + (size_t)tl * 128 + 16 * es; epf.zgp = Z + (size_t)(b * SEQ + tok0 + tl) * INC + C_G + h * 128 + 16 * es;
                hgrn_chunk<true>(lds, pf, st, oacc, segsum, c, nc0, kn < 8, epf, wid, lane, tid);
#pragma unroll
                for (int et = 0; et < 4; ++et)
#pragma unroll
                    for (int r = 0; r < 4; ++r) *(LAS float*)(lds + L_KH0 + (16 * n + 4 * fq + r) * OTP + (16 * (4 * eh + et) + fr) * 4) = oacc[et][r];
                WG_BAR();
                f32x4 o4[4];
#pragma unroll
                for (int j = 0; j < 4; ++j) o4[j] = *(const LAS f32x4*)(lds + L_KH0 + ep * OTP + (16 * es + 4 * j) * 4);
                if (dir == 0) {
                    u32x4 w0, w1;
                    w0.x = cvt_pk_bf16(o4[0][0], o4[0][1]); w0.y = cvt_pk_bf16(o4[0][2], o4[0][3]); w0.z = cvt_pk_bf16(o4[1][0], o4[1][1]); w0.w = cvt_pk_bf16(o4[1][2], o4[1][3]);
                    w1.x = cvt_pk_bf16(o4[2][0], o4[2][1]); w1.y = cvt_pk_bf16(o4[2][2], o4[2][3]); w1.z = cvt_pk_bf16(o4[3][0], o4[3][1]); w1.w = cvt_pk_bf16(o4[3][2], o4[3][3]);
                    *(GAS u32x4*)(OF + (size_t)tl * 128 + 16 * es) = w0; *(GAS u32x4*)(OF + (size_t)tl * 128 + 16 * es + 8) = w1;
                } else {
                    float ss = 0.f;
#pragma unroll
                    for (int j = 0; j < 4; ++j) { const u32x4 a = epf.of[j >> 1]; const unsigned lo = (j & 1) ? a.z : a.x, hi = (j & 1) ? a.w : a.y;
                        o4[j][0] += bf_lo(lo); o4[j][1] += bf_hi(lo); o4[j][2] += bf_lo(hi); o4[j][3] += bf_hi(hi);
                        ss += (o4[j][0] * o4[j][0] + o4[j][1] * o4[j][1]) + (o4[j][2] * o4[j][2] + o4[j][3] * o4[j][3]); }
                    ss += __shfl_xor(ss, 1); ss += __shfl_xor(ss, 2); ss += __shfl_xor(ss, 4);
                    const float rinv = 1.f / sqrtf(ss * (1.f / 128.f) + 1e-6f);
                    unsigned wo[8];
#pragma unroll
                    for (int j = 0; j < 4; ++j) { const u32x4 a = epf.zg[j >> 1]; const unsigned lo = (j & 1) ? a.z : a.x, hi = (j & 1) ? a.w : a.y;
                        const f32x4 g4 = *(const LAS f32x4*)(NW + 16 * es + 4 * j);
                        const float y0 = o4[j][0] * rinv * g4[0] * silu_f(bf_lo(lo)), y1 = o4[j][1] * rinv * g4[1] * silu_f(bf_hi(lo));
                        const float y2 = o4[j][2] * rinv * g4[2] * silu_f(bf_lo(hi)), y3 = o4[j][3] * rinv * g4[3] * silu_f(bf_hi(hi));
                        wo[2 * j] = cvt_pk_bf16(y0, y1); wo[2 * j + 1] = cvt_pk_bf16(y2, y3); }
                    bf16* yp = Y + (size_t)(b * SEQ + tok0 + tl) * DM + h * 128 + 16 * es;
                    *(GAS u32x4*)yp = (u32x4){wo[0], wo[1], wo[2], wo[3]}; *(GAS u32x4*)(yp + 8) = (u32x4){wo[4], wo[5], wo[6], wo[7]};
                }
            }
            VM_WAIT(); __syncthreads();
        }
    }
}
__device__ __forceinline__ void p6_ln1(int vcu, int G, int wave, int lane) {
    const float* mod = (const float*)(WS() + WS_CTL + CTL_MOD); bf16* H2 = (bf16*)(WS() + WS_H2); const bf16* R1 = (const bf16*)(WS() + WS_R1);
    const int gw = vcu * 8 + wave, NGW = G * 8, per = (T + NGW - 1) / NGW;
    int r0 = gw * per, r1 = r0 + per; if (r1 > T) r1 = T;
    f32x4 lw[4], lb[4];
#pragma unroll
    for (int j = 0; j < 4; ++j) { lw[j] = *(const GAS f32x4*)(IN(12) + 4 * lane + 256 * j); lb[j] = *(const GAS f32x4*)(IN(13) + 4 * lane + 256 * j); }
    int curb = -1; f32x4 sh[4], sc[4];
    for (int rb = r0; rb < r1; rb += 2) {
        const int b = rb >> 12;
        if (b != curb) { curb = b;
#pragma unroll
            for (int j = 0; j < 4; ++j) { sh[j] = *(const GAS f32x4*)(mod + b * 6144 + 3072 + 4 * lane + 256 * j); sc[j] = *(const GAS f32x4*)(mod + b * 6144 + 4096 + 4 * lane + 256 * j) + 1.f; } }
        f32x4 v[2][4]; float s[2], s2[2], mean[2], rstd[2];
#pragma unroll
        for (int q = 0; q < 2; ++q) { s[q] = 0.f;
#pragma unroll
            for (int j = 0; j < 4; ++j) { const u32x2 w = *(const GAS u32x2*)(R1 + (size_t)(rb + q) * DM + 4 * lane + 256 * j); v[q][j] = (f32x4){bf_lo(w.x), bf_hi(w.x), bf_lo(w.y), bf_hi(w.y)}; s[q] += (v[q][j].x + v[q][j].y) + (v[q][j].z + v[q][j].w); } }
#pragma unroll
        for (int q = 0; q < 2; ++q) mean[q] = wave_sum(s[q]) * (1.f / DM);
#pragma unroll
        for (int q = 0; q < 2; ++q) { s2[q] = 0.f;
#pragma unroll
            for (int j = 0; j < 4; ++j) { v[q][j] = v[q][j] - mean[q]; s2[q] += (v[q][j].x * v[q][j].x + v[q][j].y * v[q][j].y) + (v[q][j].z * v[q][j].z + v[q][j].w * v[q][j].w); } }
#pragma unroll
        for (int q = 0; q < 2; ++q) rstd[q] = 1.f / sqrtf(wave_sum(s2[q]) * (1.f / DM) + 1e-5f);
#pragma unroll
        for (int q = 0; q < 2; ++q) { s[q] = 0.f;
#pragma unroll
            for (int j = 0; j < 4; ++j) { v[q][j] = v[q][j] * rstd[q] * lw[j] + lb[j]; s[q] += (v[q][j].x + v[q][j].y) + (v[q][j].z + v[q][j].w); } }
#pragma unroll
        for (int q = 0; q < 2; ++q) mean[q] = wave_sum(s[q]) * (1.f / DM);
#pragma unroll
        for (int q = 0; q < 2; ++q) { s2[q] = 0.f;
#pragma unroll
            for (int j = 0; j < 4; ++j) { v[q][j] = v[q][j] - mean[q]; s2[q] += (v[q][j].x * v[q][j].x + v[q][j].y * v[q][j].y) + (v[q][j].z * v[q][j].z + v[q][j].w * v[q][j].w); } }
#pragma unroll
        for (int q = 0; q < 2; ++q) rstd[q] = 1.f / sqrtf(wave_sum(s2[q]) * (1.f / DM) + 1e-6f);
#pragma unroll
        for (int q = 0; q < 2; ++q) { bf16* o = H2 + (size_t)(rb + q) * DM;
#pragma unroll
            for (int j = 0; j < 4; ++j) { const f32x4 y = v[q][j] * rstd[q] * sc[j] + sh[j]; u32x2 w; w.x = cvt_pk_bf16(y.x, y.y); w.y = cvt_pk_bf16(y.z, y.w); *(GAS u32x2*)(o + 4 * lane + 256 * j) = w; } }
    }
}

__device__ __forceinline__ float rdlane(float x, int l) { return __int_as_float(__builtin_amdgcn_readlane(__float_as_int(x), l)); }
template <int CTRL> __device__ __forceinline__ float dpp_max(float x) { const int y = __builtin_amdgcn_update_dpp(__float_as_int(x), __float_as_int(x), CTRL, 0xF, 0xF, false); return fmaxf(x, __int_as_float(y)); }
__device__ __forceinline__ float group8_max(float x) { x = dpp_max<0xB1>(x); x = dpp_max<0x4E>(x); x = dpp_max<0x141>(x); return x; }
__device__ __forceinline__ float wave_max_u(float x) {
    x = group8_max(x); x = dpp_max<0x140>(x);
    const float a = rdlane(x, 0), b = rdlane(x, 16), c = rdlane(x, 32), d = rdlane(x, 48);
    return fmaxf(fmaxf(a, b), fmaxf(c, d));
}
constexpr int RWP = 1040;
__device__ __forceinline__ void p7_route(LAS unsigned char* lds, int vcu, int wave, int lane) {
    const bf16* H2 = (const bf16*)(WS() + WS_H2); const bf16* WR = (const bf16*)(WS() + WS_WR);
    int* TOKE = (int*)(WS() + WS_RT + RT_TOKE); float* TOKW = (float*)(WS() + WS_RT + RT_TOKW); int* TOKP = (int*)(WS() + WS_RT + RT_TOKP);
    unsigned* WGCNT = (unsigned*)(WS() + WS_CTL + CTL_WGCNT);
    LAS float* LG = (LAS float*)(lds + wave * 8448);
    LAS unsigned* CNT = (LAS unsigned*)(lds + 140000);
    int tid_ = threadIdx.x; asm volatile("" : "+v"(tid_)); const int tid = tid_, fr = lane & 15, fq = lane >> 4;
    if (tid < 64) CNT[tid] = 0u;
    const int r0 = vcu * 256 + wave * 32;
    f32x4 acc[2][4];
#pragma unroll
    for (int t = 0; t < 2; ++t)
#pragma unroll
        for (int et = 0; et < 4; ++et) acc[t][et] = (f32x4){0.f, 0.f, 0.f, 0.f};
    for (int kh = 0; kh < 2; ++kh) {
        __syncthreads();
#pragma unroll
        for (int i = 0; i < 16; ++i) { const int idx = tid + 512 * i, row = idx >> 6, ch = idx & 63;
            *(LAS u32x4*)(lds + row * RWP + ch * 16) = *(const GAS u32x4*)(WR + (size_t)row * DM + kh * 512 + ch * 8); }
        __syncthreads();
#pragma unroll 4
        for (int ks = 0; ks < 16; ++ks) {
            bf16x8 a[2];
#pragma unroll
            for (int t = 0; t < 2; ++t) a[t] = *(const GAS bf16x8*)(H2 + (size_t)(r0 + t * 16 + fr) * DM + kh * 512 + ks * 32 + fq * 8);
#pragma unroll
            for (int et = 0; et < 4; ++et) { const bf16x8 bh = *(const LAS bf16x8*)(lds + (et * 16 + fr) * RWP + ks * 64 + fq * 16), bl = *(const LAS bf16x8*)(lds + (64 + et * 16 + fr) * RWP + ks * 64 + fq * 16);
#pragma unroll
                for (int t = 0; t < 2; ++t) { acc[t][et] = MFMA16(a[t], bh, acc[t][et]); acc[t][et] = MFMA16(a[t], bl, acc[t][et]); } }
        }
    }
    __syncthreads();
    PSTAMP(lds, 43);
#pragma unroll
    for (int t = 0; t < 2; ++t)
#pragma unroll
        for (int et = 0; et < 4; ++et)
#pragma unroll
            for (int r = 0; r < 4; ++r) LG[(t * 16 + 4 * fq + r) * 65 + et * 16 + fr] = acc[t][et][r];
    __syncthreads();
    if (wave < 4) {
        const LAS float* L = (const LAS float*)(lds + (2 * wave + (lane >> 5)) * 8448) + (lane & 31) * 65;
        const float* biasp = IN(15);
        const int t = vcu * 256 + wave * 64 + lane;
        float sel[64];
#pragma unroll
        for (int e = 0; e < 64; ++e) sel[e] = fast_rcp(1.f + fast_exp(-L[e])) + biasp[e];
        float gs[8];
#pragma unroll
        for (int g = 0; g < 8; ++g) { float m1 = -INFINITY, m2 = -INFINITY;
#pragma unroll
            for (int j = 0; j < 8; ++j) { const float x = sel[8 * g + j]; m2 = fmaxf(m2, fminf(m1, x)); m1 = fmaxf(m1, x); }
            gs[g] = m1 + m2; }
#pragma unroll
        for (int g = 0; g < 8; ++g) { int cnt = 0;
#pragma unroll
            for (int q = 0; q < 8; ++q) if (q != g) cnt += ((gs[q] > gs[g]) || (gs[q] == gs[g] && q < g)) ? 1 : 0;
            const bool keep = cnt < 4;
#pragma unroll
            for (int j = 0; j < 8; ++j) sel[8 * g + j] = keep ? sel[8 * g + j] : -INFINITY; }
        int idx[8]; float sc[8]; float wsum = 0.f; int prev = -1;
#pragma unroll
        for (int k = 0; k < 8; ++k) { float best = -INFINITY; int bi = 0;
#pragma unroll
            for (int e = 0; e < 64; ++e) { if (k > 0) sel[e] = (prev == e) ? -INFINITY : sel[e]; const bool c = sel[e] > best; best = c ? sel[e] : best; bi = c ? e : bi; }
            idx[k] = bi; prev = bi; sc[k] = fast_rcp(1.f + fast_exp(-L[bi])); wsum += sc[k]; }
        int rk[8];
#pragma unroll
        for (int k = 0; k < 8; ++k) rk[k] = (int)atomicAdd((unsigned*)&CNT[idx[k]], 1u);
#pragma unroll
        for (int h = 0; h < 2; ++h) {
            *(GAS u32x4*)(TOKE + t * 8 + 4 * h) = (u32x4){(unsigned)idx[4 * h], (unsigned)idx[4 * h + 1], (unsigned)idx[4 * h + 2], (unsigned)idx[4 * h + 3]};
            *(GAS f32x4*)(TOKW + t * 8 + 4 * h) = (f32x4){sc[4 * h] / wsum * 2.5f, sc[4 * h + 1] / wsum * 2.5f, sc[4 * h + 2] / wsum * 2.5f, sc[4 * h + 3] / wsum * 2.5f};
            *(GAS u32x4*)(TOKP + t * 8 + 4 * h) = (u32x4){(unsigned)rk[4 * h], (unsigned)rk[4 * h + 1], (unsigned)rk[4 * h + 2], (unsigned)rk[4 * h + 3]}; }
    }
    __syncthreads();
    if (tid < 64) WGCNT[vcu * 64 + tid] = CNT[tid];
}

__device__ __forceinline__ void p8_scatter(LAS unsigned char* lds, int vcu, int wave, int lane) {
    int* TOKE = (int*)(WS() + WS_RT + RT_TOKE); int* TOKP = (int*)(WS() + WS_RT + RT_TOKP);
    int* SLOTTOK = (int*)(WS() + WS_RT + RT_SLOTTOK);
    const unsigned* WGCNT = (const unsigned*)(WS() + WS_CTL + CTL_WGCNT); int* GOFF = (int*)(WS() + WS_SMALL + 16384);
    LAS int* TOTL = (LAS int*)lds; LAS int* PRE = TOTL + 128; LAS int* GO = PRE + 128; LAS int* PT = GO + 160; LAS int* PP = PT + 512;
    int tid_ = threadIdx.x; asm volatile("" : "+v"(tid_)); const int tid = tid_, myh = vcu >> 7;
    { const int e = tid & 63, part = tid >> 6; int tot = 0, pre = 0;
#pragma unroll 8
      for (int w = 0; w < 32; ++w) { const int v = part * 32 + w; const int c = (int)WGCNT[v * 64 + e]; tot += c; pre += (v < vcu) ? c : 0; }
      PT[part * 64 + e] = tot; PP[part * 64 + e] = pre; }
    __syncthreads();
    if (tid < 128) { const int h = tid >> 6, e = tid & 63;
        TOTL[tid] = PT[(4 * h) * 64 + e] + PT[(4 * h + 1) * 64 + e] + PT[(4 * h + 2) * 64 + e] + PT[(4 * h + 3) * 64 + e];
        if (h == myh) PRE[e] = PP[(4 * h) * 64 + e] + PP[(4 * h + 1) * 64 + e] + PP[(4 * h + 2) * 64 + e] + PP[(4 * h + 3) * 64 + e]; }
    __syncthreads();
    if (tid < 2) { int off = 0; for (int e = 0; e < 64; ++e) { GO[tid * 66 + e] = off; off += (TOTL[tid * 64 + e] + 255) & ~255; } GO[tid * 66 + 64] = off; GO[tid * 66 + 65] = off + HALF_T; }
    __syncthreads();
    if (vcu == 0) {
        if (tid < 132) GOFF[tid] = GO[tid];
        if (tid < 128) { const int h = tid >> 6, e = tid & 63; const int beg = GO[h * 66 + e] + TOTL[tid], end = GO[h * 66 + e + 1];
            for (int s = beg; s < end; ++s) SLOTTOK[h * HCAP + s] = h * HALF_T; }
    }
    const int r0 = vcu * 256 + wave * 32;
#pragma unroll
    for (int it = 0; it < 4; ++it) { const int t = r0 + it * 8 + (lane >> 3), k = lane & 7;
        const int e = TOKE[t * 8 + k]; const int slot = GO[myh * 66 + e] + PRE[e] + TOKP[t * 8 + k];
        SLOTTOK[myh * HCAP + slot] = t; TOKP[t * 8 + k] = slot; }
    if (lane < 32) { const int t = r0 + lane; SLOTTOK[myh * HCAP + GO[myh * 66 + 64] + (t - myh * HALF_T)] = t; }
    __syncthreads();
}

template <int NN  , bool GATHER, int NG  >
struct GroupedOrder {
    const LAS int* GT; const char* A; const char* B; const int* sl; int G, c, K; size_t bgroup;
    __device__ __forceinline__ void init(LAS int* gt, const int* GOFF, int half, const void* A_, const void* B_, const int* slottok, int K_, size_t bgroup_bytes, int G_, int c_) {
        int tx = threadIdx.x; asm volatile("" : "+v"(tx));
        LAS int* szp = gt - 512;
        if ((int)tx < NG) { const int q = tx, h = (NG == 130) ? q / NE1 : half, e = q % NE1; const int g0 = GOFF[h * 66 + e], g1 = GOFF[h * 66 + e + 1];
            szp[q] = ((g1 - g0) >> 8) * NN; gt[132 + q] = h * HCAP + g0; }
        __syncthreads();
        if ((int)tx <= NG) { int cum = 0;
#pragma unroll 1
            for (int q = 0; q < (int)tx; ++q) cum += szp[q];
            gt[tx] = cum; }
        __syncthreads();
        if (tx < 32) { const int L = (int)tx * G_ + c_; int t0 = 0, t1 = 0, t2 = 0, t3 = 0;
            if (L < gt[NG]) { int lo = 0, hi = NG - 1;
#pragma unroll 1
                for (int it = 0; it < 8; ++it) if (lo < hi) { const int mid = (lo + hi + 1) >> 1; if (gt[mid] <= L) lo = mid; else hi = mid - 1; }
                const int local = L - gt[lo], mt = local / NN, nt = local - mt * NN;
                t0 = (gt[132 + lo] >> 8) + mt; t1 = nt; t2 = lo; t3 = 1; }
            *(LAS u32x4*)(gt + 272 + 4 * tx) = (u32x4){(unsigned)t0, (unsigned)t1, (unsigned)t2, (unsigned)t3}; }
        __syncthreads();
        GT = gt; A = (const char*)A_; B = (const char*)B_; sl = slottok; G = G_; c = c_; K = K_; bgroup = bgroup_bytes;
    }
    __device__ __forceinline__ bool next(int i, pg8::Unit& u) const {
#define RFL(x) __builtin_amdgcn_readfirstlane(x)
        if (i >= 32) return false;
        const u32x4 t = *(const LAS u32x4*)(GT + 272 + 4 * i);
        if (RFL((int)t.w) == 0) return false;
        const int q = RFL((int)t.z), nt = RFL((int)t.y), e = (q >= NE1) ? q - NE1 : q;
        u.pm = RFL((int)t.x); u.pn = nt; u.aux = q;
#undef RFL
        u.b = B + (size_t)e * bgroup + (size_t)nt * 256 * K * 2;
        if (GATHER) { u.a = A; u.gidx = sl + u.pm * 256; } else { u.a = A + (size_t)u.pm * 256 * K * 2; u.gidx = nullptr; }
        return true;
    }
};
struct EpiAct {
#ifdef EXP_DOUBLE_EPI
    static constexpr bool DOUBLE = (EXP_DOUBLE_EPI == 3);
#endif
    bf16* ACT;
    __device__ __forceinline__ void operator()(const acc_t& acc, const pg8::Unit& u, int wr, int wc, int fr, int fq) const {
        const int row0 = u.pm * 256 + wr * 64 + fr, col = u.pn * 128 + wc * 32 + 8 * fq;
#pragma unroll
        for (int ai = 0; ai < 2; ++ai)
#pragma unroll
            for (int m = 0; m < 4; ++m) { float o[8];
#pragma unroll
                for (int n = 0; n < 2; ++n)
#pragma unroll
                    for (int j = 0; j < 4; ++j) { const float gte = acc[ai][0][m][n][j]; o[4 * n + j] = gte * fast_rcp(1.f + fast_exp(-gte)) * acc[ai][1][m][n][j]; }
                u32x4 w; w.x = cvt_pk_bf16(o[0], o[1]); w.y = cvt_pk_bf16(o[2], o[3]); w.z = cvt_pk_bf16(o[4], o[5]); w.w = cvt_pk_bf16(o[6], o[7]);
                *(GAS u32x4*)((unsigned char*)ACT + ((unsigned)(row0 + ai * 128 + m * 16) * FF + (unsigned)col) * 2u) = w; }
    }
};
__device__ __forceinline__ unsigned pk4_fp8(f32x4 v) {
    v[0] = __builtin_amdgcn_fmed3f(v[0], -448.f, 448.f); v[1] = __builtin_amdgcn_fmed3f(v[1], -448.f, 448.f); v[2] = __builtin_amdgcn_fmed3f(v[2], -448.f, 448.f); v[3] = __builtin_amdgcn_fmed3f(v[3], -448.f, 448.f);
    int p = __builtin_amdgcn_cvt_pk_fp8_f32(v[0], v[1], 0, false); p = __builtin_amdgcn_cvt_pk_fp8_f32(v[2], v[3], p, true); return (unsigned)p; }
struct EpiDown {
#ifdef EXP_DOUBLE_EPI
    static constexpr bool DOUBLE = (EXP_DOUBLE_EPI == 4);
#endif
    unsigned char* SO; int rowbase;
    __device__ __forceinline__ void operator()(const acc_t& acc, const pg8::Unit& u, int wr, int wc, int fr, int fq) const {
        const int row0 = u.pm * 256 + wr * 64 + fr;
#pragma unroll
        for (int ai = 0; ai < 2; ++ai)
#pragma unroll
            for (int m = 0; m < 4; ++m) { const int row = row0 + ai * 128 + m * 16; const float g = 1.f;
                const unsigned a0 = pk4_fp8(acc[ai][0][m][0] * g), a1 = pk4_fp8(acc[ai][0][m][1] * g), b0 = pk4_fp8(acc[ai][1][m][0] * g), b1 = pk4_fp8(acc[ai][1][m][1] * g);
                const auto s0 = __builtin_amdgcn_permlane16_swap(a0, b0, false, false), s1 = __builtin_amdgcn_permlane16_swap(a1, b1, false, false);
                const u32x4 w = (u32x4){s0[0], s1[0], s0[1], s1[1]};
                *(GAS u32x4*)(SO + ((unsigned)(row - rowbase) * DM + (unsigned)(u.pn * 256 + (fq & 1) * 128 + wc * 32 + 8 * (fq & 2)))) = w; }
    }
};

__device__ __forceinline__ void p11_combine(int half, int vcu, int G, int wave, int lane_) {
    int lane = lane_; asm volatile("" : "+v"(lane));
    const float* mod = (const float*)(WS() + WS_CTL + CTL_MOD); const unsigned char* SO = (const unsigned char*)(WS() + WS_SO);
    const int* TOKP = (const int*)(WS() + WS_RT + RT_TOKP); const float* TOKW = (const float*)(WS() + WS_RT + RT_TOKW); const int* GOFF = (const int*)(WS() + WS_SMALL + 16384);
    const bf16* X1 = (const bf16*)(WS() + WS_R1); float* OUTP = OUT();
    const int gw = vcu * 8 + wave, NGW = G * 8, per = (HALF_T + NGW - 1) / NGW;
    int r0 = gw * per, r1 = r0 + per; if (r1 > HALF_T) r1 = HALF_T;
    const int shbase = GOFF[half * 66 + 64];
    f32x4 lw[4], lb[4], g2[4]; int curb = -1;
#pragma unroll
    for (int j = 0; j < 4; ++j) { const int col = 16 * lane + 4 * j; lw[j] = *(const GAS f32x4*)(IN(22) + col); lb[j] = *(const GAS f32x4*)(IN(23) + col); }
    f32x4 lw1[4], lb1[4];
#pragma unroll
    for (int j = 0; j < 4; ++j) { const int col = 16 * lane + 4 * j; lw1[j] = *(const GAS f32x4*)(IN(12) + col); lb1[j] = *(const GAS f32x4*)(IN(13) + col); }
    for (int rb = r0; rb < r1; rb += 2) {
        u32x4 raw[2][9], xw[2][2]; float gate[2];
#pragma unroll
        for (int q = 0; q < 2; ++q) { const int r = rb + q, t = half * HALF_T + r;
            const int slot = (lane < 8) ? TOKP[t * 8 + lane] : (shbase + r); gate[q] = (lane < 8) ? TOKW[t * 8 + lane] : 1.f;
#pragma unroll
            for (int k = 0; k < 9; ++k) { const int sk = __shfl(slot, k); raw[q][k] = *(const GAS u32x4*)(SO + (size_t)sk * DM + 16 * lane); }
            xw[q][0] = *(const GAS u32x4*)(X1 + (size_t)t * DM + 16 * lane); xw[q][1] = *(const GAS u32x4*)(X1 + (size_t)t * DM + 16 * lane + 8); }
#pragma unroll
        for (int q = 0; q < 2; ++q) { const int r = rb + q, t = half * HALF_T + r, b = t >> 12;
            if (b != curb) { curb = b;
#pragma unroll
                for (int j = 0; j < 4; ++j) g2[j] = *(const GAS f32x4*)(mod + b * 6144 + 5120 + 16 * lane + 4 * j) * (1.f / SO_SCALE); }
            float* xr = OUTP + (size_t)t * DM; f32x4 v[4];
            { const u32x4 a = xw[q][0], c = xw[q][1];
              v[0] = (f32x4){bf_lo(a.x), bf_hi(a.x), bf_lo(a.y), bf_hi(a.y)}; v[1] = (f32x4){bf_lo(a.z), bf_hi(a.z), bf_lo(a.w), bf_hi(a.w)};
              v[2] = (f32x4){bf_lo(c.x), bf_hi(c.x), bf_lo(c.y), bf_hi(c.y)}; v[3] = (f32x4){bf_lo(c.z), bf_hi(c.z), bf_lo(c.w), bf_hi(c.w)}; }
            { float s1 = 0.f;
#pragma unroll
              for (int j = 0; j < 4; ++j) s1 += (v[j].x + v[j].y) + (v[j].z + v[j].w);
              const float mean1 = wave_sum(s1) * (1.f / DM); float q1 = 0.f;
#pragma unroll
              for (int j = 0; j < 4; ++j) { v[j] = v[j] - mean1; q1 += (v[j].x * v[j].x + v[j].y * v[j].y) + (v[j].z * v[j].z + v[j].w * v[j].w); }
              const float rstd1 = 1.f / sqrtf(wave_sum(q1) * (1.f / DM) + 1e-5f);
#pragma unroll
              for (int j = 0; j < 4; ++j) v[j] = v[j] * rstd1 * lw1[j] + lb1[j]; }
            f32x4 y[4];
#pragma unroll
            for (int j = 0; j < 4; ++j) y[j] = (f32x4){0.f, 0.f, 0.f, 0.f};
#pragma unroll
            for (int k = 0; k < 9; ++k) { const float gk = __shfl(gate[q], k);
#pragma unroll
                for (int j = 0; j < 4; ++j) { const f32x2 a = __builtin_amdgcn_cvt_pk_f32_fp8((int)raw[q][k][j], false), c = __builtin_amdgcn_cvt_pk_f32_fp8((int)raw[q][k][j], true); y[j] += (f32x4){a.x, a.y, c.x, c.y} * gk; } }
            float s = 0.f;
#pragma unroll
            for (int j = 0; j < 4; ++j) { v[j] = v[j] * ALPHA + g2[j] * y[j]; s += (v[j].x + v[j].y) + (v[j].z + v[j].w); }
            const float mean = wave_sum(s) * (1.f / DM); float s2 = 0.f;
#pragma unroll
            for (int j = 0; j < 4; ++j) { v[j] = v[j] - mean; s2 += (v[j].x * v[j].x + v[j].y * v[j].y) + (v[j].z * v[j].z + v[j].w * v[j].w); }
            const float rstd = 1.f / sqrtf(wave_sum(s2) * (1.f / DM) + 1e-5f);
#pragma unroll
            for (int j = 0; j < 4; ++j) *(GAS f32x4*)(xr + 16 * lane + 4 * j) = v[j] * rstd * lw[j] + lb[j];
        }
    }
}
#ifndef MOE_ALIGN
#define MOE_ALIGN true
#endif
#ifndef PHMASK
#define PHMASK 0xffffffffu
#endif
#define PH(k) ((PHMASK >> (k)) & 1u)
#define CODE_SHIFT_STR_(x) #x
#define CODE_SHIFT_STR__(x) CODE_SHIFT_STR_(x)
#define CODE_SHIFT_STR CODE_SHIFT_STR__(CODE_SHIFT_NOPS)
#ifdef PROBE_A
constexpr bool P10_PEEL = false;
#else
constexpr bool P10_PEEL = true;
#endif
__global__ void __launch_bounds__(512, 2) mk_fwd(Ptrs P) {
    extern __shared__ __attribute__((aligned(16))) unsigned char lds_raw[];
    LAS unsigned char* lds = (LAS unsigned char*)lds_raw;
    const int tid = threadIdx.x, lane = tid & 63, wave = __builtin_amdgcn_readfirstlane(tid >> 6);
    const int G = gridDim.x; const int bx = blockIdx.x; const int vcu = (G % 8 == 0) ? (bx % 8) * (G / 8) + bx / 8 : bx;
    volatile LAS unsigned* MISC = (volatile LAS unsigned*)(lds + MISC_TOP);
    if (tid < 128) MISC[tid] = 0u;
    __syncthreads();
    unsigned char* ws = WS();
#ifdef PROBE_A
    volatile LAS unsigned long long* STP = (volatile LAS unsigned long long*)(lds + MISC_TOP + 64);
    int n_stamp = 0;
#define STAMP() do { if (blockIdx.x == 0 && threadIdx.x == 0 && n_stamp < 20) STP[n_stamp] = __builtin_amdgcn_s_memrealtime(); ++n_stamp; } while (0)
    STAMP();
#else
#define STAMP() do {} while (0)
#endif
    gu32* ctl = (gu32*)(ws + WS_CTL);
    XcdBarrier bar = xcd_barrier_post((unsigned*)(ctl + CW_BAR), MISC + 8);
(void)bar;
#define GRID_BAR() do { XcdBarrier b_; b_.bar = (unsigned*)(WS() + WS_CTL) + CW_BAR; b_.x = (unsigned)__builtin_amdgcn_readfirstlane((int)xb_xcc_id()); b_.st = (volatile LAS unsigned*)(lds + MISC_TOP) + 8; xcd_barrier(b_); STAMP(); } while (0)

#ifdef CODE_SHIFT_NOPS
    asm volatile(".rept " CODE_SHIFT_STR "\n\ts_nop 0\n\t.endr");
#endif
    if (PH(0)) { p0a_mod(lds, vcu, G, wave, lane); p0_prologue(lds, vcu, G, wave, lane); }
    GRID_BAR();
    if (PH(1)) { p1_mod_reduce(vcu, wave, lane); p1_modulate(lds, vcu, G, wave, lane); }
    GRID_BAR();
    if (PH(2)) { pg8::DenseOrder S; S.init(ws + WS_H, ws + WS_WIN, MALL, INC, DM, G, bx);
      EpiZ E{(bf16*)(ws + WS_Z), (const float*)(ws + WS_SMALL), (const f32x2*)(ws + WS_SMALL + 4096)};
      pg8::gemm_phase<EpiZ, pg8::DenseOrder, false>(lds, lds + GIDX_OFF, DM, S, E); }
    GRID_BAR();
    if (wave >= 4) __builtin_amdgcn_s_setprio(1);
    if (PH(3)) attn_phase(lds, vcu, G);
    PSTAMP(lds, 40);
    if (PH(4)) hgrn_pass_a(lds, vcu, G);
    PSTAMP(lds, 41);
    __builtin_amdgcn_s_setprio(0);
    GRID_BAR();
    if (wave >= 4) __builtin_amdgcn_s_setprio(1);
    if (PH(5)) hgrn_pass_c(lds, vcu, G);
    __builtin_amdgcn_s_setprio(0);
    GRID_BAR();
    if (PH(6)) { pg8::DenseOrder S; S.init(ws + WS_Y, ws + WS_WOUT, T, DM, DM, G, bx);
      EpiR1 E{IN(0), (const float*)(ws + WS_CTL + CTL_MOD), (bf16*)(ws + WS_R1)};
      pg8::gemm_phase<EpiR1, pg8::DenseOrder, false>(lds, lds + GIDX_OFF, DM, S, E); }
    GRID_BAR();
    if (PH(7)) p6_ln1(vcu, G, wave, lane);
    VM_WAIT(); __syncthreads();
    STAMP();
    if (PH(8)) p7_route(lds, vcu, wave, lane);
    PSTAMP(lds, 42);
    GRID_BAR();
    if (PH(9)) p8_scatter(lds, vcu, wave, lane);
    GRID_BAR();
    const int* GOFFp = (const int*)(ws + WS_SMALL + 16384);
    const int* sl_all = (const int*)(ws + WS_RT + RT_SLOTTOK);
    if (PH(10)) { GroupedOrder<2, true, 130> S; S.init((LAS int*)(lds + GTAB_OFF), GOFFp, 0, ws + WS_H2, ws + WS_WGU, sl_all, DM, (size_t)512 * DM * 2, G, vcu);
      EpiAct E{(bf16*)(ws + WS_ACT)};
      pg8::gemm_phase<EpiAct, GroupedOrder<2, true, 130>, true, MOE_ALIGN>(lds, lds + GIDX_OFF, DM, S, E); }
    GRID_BAR();
#pragma unroll
    for (int half = 0; half < 2; ++half) {
        if (PH(11)) { GroupedOrder<4, false, 65> S; S.init((LAS int*)(lds + GTAB_OFF), GOFFp, half, ws + WS_ACT, ws + WS_WD, sl_all, FF, (size_t)DM * FF * 2, G, vcu);
          EpiDown E{(unsigned char*)(ws + WS_SO), half * HCAP};
          pg8::gemm_phase<EpiDown, GroupedOrder<4, false, 65>, false, MOE_ALIGN, P10_PEEL>(lds, lds + GIDX_OFF, FF, S, E); }
        GRID_BAR();
        if (PH(12)) p11_combine(half, vcu, G, wave, lane);
        if (half == 0) GRID_BAR(); else STAMP();
    }
#ifdef PROBE_A
#ifndef PROBE_SCALE
#define PROBE_SCALE 1e-3f
#endif
#ifndef PROBE_OFF
#define PROBE_OFF 0
#endif
    GRID_BAR();
    if (blockIdx.x == 0) {
        const float v1 = 3.0f + (float)((long long)(STP[PROBE_A] - STP[PROBE_A0]) - (long long)(PROBE_OFF)) * PROBE_SCALE;
        float* o = OUT();
        if (threadIdx.x == 0) o[0] += v1;
#pragma unroll 1
        for (int i = threadIdx.x; i < 65536; i += 512) o[1024 + i] += 2.0f;
    }
#endif
}

extern "C" void kernel_launch(void* const* d_in, const int* in_sizes, int n_in, void* d_out, int out_size, void* d_ws, size_t ws_size, hipStream_t stream) {
    static int ready = 0;
    if (ready == 0) {
        if (n_in != 24 || in_sizes[0] != T * DM || out_size != T * DM || ws_size < WS_END) { fprintf(stderr, "kernel_launch: unexpected problem shape (n_in %d, in0 %d, out %d, ws %zu); nothing launched\n", n_in, n_in > 0 ? in_sizes[0] : -1, out_size, ws_size); ready = -1; return; }
        if (hipFuncSetAttribute((const void*)mk_fwd, hipFuncAttributeMaxDynamicSharedMemorySize, LDS_BYTES) != hipSuccess) { fprintf(stderr, "kernel_launch: hipFuncSetAttribute failed\n"); ready = -1; return; }
        int per_cu = 0;
        if (hipOccupancyMaxActiveBlocksPerMultiprocessor(&per_cu, (const void*)mk_fwd, 512, LDS_BYTES) != hipSuccess || per_cu < 1) fprintf(stderr, "kernel_launch: note: occupancy query reports %d workgroups per CU\n", per_cu);
        (void)hipGetLastError();
        ready = 1;
    }
    if (ready < 0) return;
    if (hipMemsetAsync((char*)d_ws + WS_CTL, 0, CTL_ZERO_BYTES, stream) != hipSuccess) { fprintf(stderr, "kernel_launch: memset failed\n"); return; }
    Ptrs p{};
    for (int i = 0; i < 24; ++i) p.in[i] = (const float*)d_in[i];
    p.out = (float*)d_out; p.ws = (unsigned char*)d_ws;
    hipLaunchKernelGGL(mk_fwd, dim3(256), dim3(512), LDS_BYTES, stream, p);
}
```
